# Optimizing an MI355X kernel written in HIP

```python
import jax, jax.numpy as jnp
from jax import lax
import numpy as np

D_MODEL = 4096
BATCH = 4
SEQ = 4096
DEPTH = 1

D_LRU = D_MODEL // 2
N_LRU_BLOCKS = 16
LRU_BLOCK = D_LRU // N_LRU_BLOCKS
LRU_C = 8.0
CONV_LRU = 4
HEAD_DIM = 128
N_HEADS = (D_MODEL // 2) // HEAD_DIM
N_KV_HEADS = 4
D_ATTN = N_HEADS * HEAD_DIM
D_KV = N_KV_HEADS * HEAD_DIM
D_MIX = D_LRU + D_ATTN
N_IDX_HEADS = 32
IDX_DIM = 64
TOPK_MAX = 256
Q_BLOCK = 128
D_FF = 11008
CONV_FFN = 3
RMS_EPS = 1e-6
N_MOD = 6

SZ_LRU_X = D_LRU
SZ_LRU_GATE = D_LRU
SZ_Q = D_ATTN
SZ_K = D_KV
SZ_V = D_KV
SZ_QIDX = N_IDX_HEADS * IDX_DIM
SZ_KIDX = IDX_DIM
SZ_WIDX = N_IDX_HEADS
D_IN = SZ_LRU_X + SZ_LRU_GATE + SZ_Q + SZ_K + SZ_V + SZ_QIDX + SZ_KIDX + SZ_WIDX
OFF_1 = SZ_LRU_X
OFF_2 = OFF_1 + SZ_LRU_GATE
OFF_3 = OFF_2 + SZ_Q
OFF_4 = OFF_3 + SZ_K
OFF_5 = OFF_4 + SZ_V
OFF_6 = OFF_5 + SZ_QIDX
OFF_7 = OFF_6 + SZ_KIDX

kernel_name = "hymba_rglru_dsa_convffn_adaln"


def rmsnorm(x, g):
    xf = x.astype(jnp.float32)
    y = xf * lax.rsqrt(jnp.mean(xf * xf, axis=-1, keepdims=True) + RMS_EPS)
    return (y * g.astype(jnp.float32)).astype(x.dtype)


def causal_dwconv(x, w, b):
    k_w = w.shape[0]
    s = x.shape[1]
    xp = jnp.pad(x, ((0, 0), (k_w - 1, 0), (0, 0)))
    y = b
    for j in range(k_w):
        y = y + w[j] * xp[:, j:j + s]
    return y


def rg_lru(x, w_a, b_a, w_x, b_x, lam):
    f32 = jnp.float32
    bsz, s, _ = x.shape
    xf = x.astype(f32)
    xb = xf.reshape(bsz, s, N_LRU_BLOCKS, LRU_BLOCK)
    r = jax.nn.sigmoid(jnp.einsum('bsni,nij->bsnj', xb, w_a.astype(f32)).reshape(bsz, s, D_LRU) + b_a.astype(f32))
    i = jax.nn.sigmoid(jnp.einsum('bsni,nij->bsnj', xb, w_x.astype(f32)).reshape(bsz, s, D_LRU) + b_x.astype(f32))
    log_a = -LRU_C * jax.nn.softplus(-lam.astype(f32)) * r
    a = jnp.exp(log_a)
    u = jnp.sqrt(-jnp.expm1(2.0 * log_a)) * (i * xf)

    def combine(e1, e2):
        a1, b1 = e1
        a2, b2 = e2
        return a1 * a2, a2 * b1 + b2

    _, h = lax.associative_scan(combine, (a, u), axis=1)
    return h.astype(x.dtype)


def dsa_attention(q, k, v, q_idx, k_idx, w_idx):
    f32 = jnp.float32
    bsz, s = q.shape[0], q.shape[1]
    n_blk = s // Q_BLOCK
    k_sel = min(TOPK_MAX, s // 4)
    rep = N_HEADS // N_KV_HEADS
    scale = HEAD_DIM ** -0.5
    k_idx_f = k_idx.astype(f32)
    key_pos = jnp.arange(s)

    def to_blocks(t):
        return jnp.swapaxes(t.reshape((bsz, n_blk, Q_BLOCK) + t.shape[2:]), 0, 1)

    def gather_rows(kb, ib):
        return kb[ib]

    def block(args):
        qb, qib, wib, t0 = args
        qpos = t0 + jnp.arange(Q_BLOCK)
        causal = key_pos[None, :] <= qpos[:, None]
        dots = jnp.einsum('bqhd,bsd->bqhs', qib.astype(f32), k_idx_f)
        score = jnp.einsum('bqhs,bqh->bqs', jax.nn.relu(dots), wib.astype(f32))
        score = jnp.where(causal[None], score, -jnp.inf)
        _, sel = lax.top_k(score, k_sel)
        valid = sel <= qpos[None, :, None]
        kg = jax.vmap(gather_rows)(k, sel)
        vg = jax.vmap(gather_rows)(v, sel)
        qg = qb.reshape(bsz, Q_BLOCK, N_KV_HEADS, rep, HEAD_DIM).astype(f32)
        logits = jnp.einsum('bqgrd,bqkgd->bqgrk', qg, kg.astype(f32)) * scale
        logits = jnp.where(valid[:, :, None, None, :], logits, -jnp.inf)
        p = jax.nn.softmax(logits, axis=-1)
        o = jnp.einsum('bqgrk,bqkgd->bqgrd', p, vg.astype(f32))
        return o.reshape(bsz, Q_BLOCK, D_ATTN).astype(q.dtype)

    t0s = jnp.arange(n_blk) * Q_BLOCK
    out = lax.map(block, (to_blocks(q), to_blocks(q_idx), to_blocks(w_idx), t0s))
    return jnp.swapaxes(out, 0, 1).reshape(bsz, s, D_ATTN)


def hybrid_layer(x, c, w_ada, b_ada, g_pre_mix, g_post_mix, g_pre_ffn, g_post_ffn, w_in,
                 conv_lru_w, conv_lru_b, w_rg_a, b_rg_a, w_rg_x, b_rg_x, lru_lambda,
                 g_grp_lru, g_grp_attn, w_out, w_ffn_in, conv_ffn_w, conv_ffn_b, w_ffn_out):
    bsz, s, _ = x.shape
    mod = (jax.nn.silu(c) @ w_ada + b_ada)[:, None, :]
    sh1, sc1, gt1, sh2, sc2, gt2 = jnp.split(mod, N_MOD, axis=-1)

    h = rmsnorm(x, g_pre_mix) * (1.0 + sc1) + sh1
    proj = h @ w_in
    x_lru, gate_lru, q, k, v, q_idx, k_idx, w_idx = jnp.split(
        proj, [OFF_1, OFF_2, OFF_3, OFF_4, OFF_5, OFF_6, OFF_7], axis=-1)

    x_lru = causal_dwconv(x_lru, conv_lru_w, conv_lru_b)
    y_lru = rg_lru(x_lru, w_rg_a, b_rg_a, w_rg_x, b_rg_x, lru_lambda) * jax.nn.gelu(gate_lru)

    y_attn = dsa_attention(q.reshape(bsz, s, N_HEADS, HEAD_DIM),
                           k.reshape(bsz, s, N_KV_HEADS, HEAD_DIM),
                           v.reshape(bsz, s, N_KV_HEADS, HEAD_DIM),
                           q_idx.reshape(bsz, s, N_IDX_HEADS, IDX_DIM), k_idx, w_idx)

    merged = jnp.concatenate([rmsnorm(y_lru, g_grp_lru), rmsnorm(y_attn, g_grp_attn)], axis=-1)
    mix = merged @ w_out
    x = x + gt1 * rmsnorm(mix, g_post_mix)

    h = rmsnorm(x, g_pre_ffn) * (1.0 + sc2) + sh2
    u = causal_dwconv(h @ w_ffn_in, conv_ffn_w, conv_ffn_b)
    u_gate, u_up = jnp.split(u, 2, axis=-1)
    f = (jax.nn.gelu(u_gate) * u_up) @ w_ffn_out
    return x + gt2 * rmsnorm(f, g_post_ffn)


def setup_inputs(seed: int = 0) -> dict:
    key = jax.random.key(seed)
    ks = jax.random.split(key, 24)
    f32 = jnp.float32
    nrm = lambda k, shape, s: jax.random.normal(k, shape, f32) * s
    L = DEPTH
    u = jax.random.uniform(ks[15], (L, D_LRU), f32, 0.9, 0.999)
    a0 = u ** (1.0 / LRU_C)
    lru_lambda = jnp.log(a0) - jnp.log1p(-a0)
    return {
        'x': nrm(ks[0], (BATCH, SEQ, D_MODEL), 1.0),
        'c': nrm(ks[1], (BATCH, D_MODEL), 1.0),
        'w_ada': nrm(ks[2], (L, D_MODEL, N_MOD * D_MODEL), 0.5 * D_MODEL ** -0.5),
        'b_ada': nrm(ks[3], (L, N_MOD * D_MODEL), 0.02),
        'g_pre_mix': 1.0 + nrm(ks[4], (L, D_MODEL), 0.02),
        'g_post_mix': 1.0 + nrm(ks[5], (L, D_MODEL), 0.02),
        'g_pre_ffn': 1.0 + nrm(ks[6], (L, D_MODEL), 0.02),
        'g_post_ffn': 1.0 + nrm(ks[7], (L, D_MODEL), 0.02),
        'w_in': nrm(ks[8], (L, D_MODEL, D_IN), D_MODEL ** -0.5),
        'conv_lru_w': nrm(ks[9], (L, CONV_LRU, D_LRU), CONV_LRU ** -0.5),
        'conv_lru_b': nrm(ks[10], (L, D_LRU), 0.02),
        'w_rg_a': nrm(ks[11], (L, N_LRU_BLOCKS, LRU_BLOCK, LRU_BLOCK), LRU_BLOCK ** -0.5),
        'b_rg_a': nrm(ks[12], (L, D_LRU), 0.02),
        'w_rg_x': nrm(ks[13], (L, N_LRU_BLOCKS, LRU_BLOCK, LRU_BLOCK), LRU_BLOCK ** -0.5),
        'b_rg_x': nrm(ks[14], (L, D_LRU), 0.02),
        'lru_lambda': lru_lambda,
        'g_grp_lru': 1.0 + nrm(ks[16], (L, D_LRU), 0.02),
        'g_grp_attn': 1.0 + nrm(ks[17], (L, D_ATTN), 0.02),
        'w_out': nrm(ks[18], (L, D_MIX, D_MODEL), D_MIX ** -0.5),
        'w_ffn_in': nrm(ks[19], (L, D_MODEL, 2 * D_FF), D_MODEL ** -0.5),
        'conv_ffn_w': nrm(ks[20], (L, CONV_FFN, 2 * D_FF), CONV_FFN ** -0.5),
        'conv_ffn_b': nrm(ks[21], (L, 2 * D_FF), 0.02),
        'w_ffn_out': nrm(ks[22], (L, D_FF, D_MODEL), D_FF ** -0.5),
    }


def reference(x, c, w_ada, b_ada, g_pre_mix, g_post_mix, g_pre_ffn, g_post_ffn, w_in,
              conv_lru_w, conv_lru_b, w_rg_a, b_rg_a, w_rg_x, b_rg_x, lru_lambda,
              g_grp_lru, g_grp_attn, w_out, w_ffn_in, conv_ffn_w, conv_ffn_b, w_ffn_out):
    for l in range(DEPTH):
        x = hybrid_layer(x, c, w_ada[l], b_ada[l], g_pre_mix[l], g_post_mix[l], g_pre_ffn[l],
                         g_post_ffn[l], w_in[l], conv_lru_w[l], conv_lru_b[l], w_rg_a[l], b_rg_a[l],
                         w_rg_x[l], b_rg_x[l], lru_lambda[l], g_grp_lru[l], g_grp_attn[l], w_out[l],
                         w_ffn_in[l], conv_ffn_w[l], conv_ffn_b[l], w_ffn_out[l])
    return x
```

```cpp
#include <hip/hip_runtime.h>
#include <cstdio>
#include <cstdint>

#ifndef MK_N_LAUNCHES
#define MK_N_LAUNCHES 1
#endif

#ifndef MK_PREP
#define MK_PREP 2
#endif
#ifndef MK_PROBE
#define MK_PROBE -1
#endif
#ifndef P4_DIRECT
#define P4_DIRECT 0
#endif
#ifndef MK_DIAG
#define MK_DIAG 0
#endif
#define LAS __attribute__((address_space(3)))
#define GAS __attribute__((address_space(1)))
typedef _Float16 f16;
typedef _Float16 f16x2 __attribute__((ext_vector_type(2)));
typedef _Float16 f16x8 __attribute__((ext_vector_type(8)));
typedef short s16x8 __attribute__((ext_vector_type(8)));
typedef float f32x4 __attribute__((ext_vector_type(4)));
typedef float f32x2 __attribute__((ext_vector_type(2)));
typedef unsigned u32x4 __attribute__((ext_vector_type(4)));
typedef unsigned u32x2 __attribute__((ext_vector_type(2)));
typedef unsigned short u16;
typedef int i32x2 __attribute__((ext_vector_type(2)));
typedef int i32x4 __attribute__((ext_vector_type(4)));
typedef int i32x8 __attribute__((ext_vector_type(8)));

constexpr int BATCH = 4, SEQ = 4096, DM = 4096, M = BATCH * SEQ;
constexpr int DLRU = 2048, NLB = 16, LB = 128, DATT = 2048, DKV = 512, NH = 16, NKV = 4, HD = 128, NIH = 32, IDIM = 64;
constexpr int DIN = 9312, DINP = 9472, DFF = 11008, DFF2 = 22016, TOPK = 256, NMOD = 6 * DM;
constexpr float RMS_EPS = 1e-6f;
constexpr float ATT_SCALE = 0.08838834764831845f;
constexpr int NWAVES = 8, NTHR = 512;

constexpr size_t MiB = 1u << 20;
constexpr size_t WS_CTL = 0, CTL_ZERO_BYTES = 1 * MiB;
constexpr size_t WS_MOD = 1 * MiB;
constexpr size_t WS_WIN = 2 * MiB;
constexpr size_t WS_WOUT = WS_WIN + 74 * MiB;
constexpr size_t WS_WFI = WS_WOUT + 32 * MiB;
constexpr size_t WS_WFO = WS_WFI + 172 * MiB;
constexpr size_t WS_H = WS_WFO + 86 * MiB;
constexpr size_t WS_XL = WS_H + 128 * MiB;
constexpr size_t WS_GATE = WS_XL + 64 * MiB;
constexpr size_t WS_Q = WS_GATE + 64 * MiB;
constexpr size_t WS_K = WS_Q + 64 * MiB;
constexpr size_t WS_V = WS_K + 16 * MiB;
constexpr size_t WS_QI = WS_V + 16 * MiB;
constexpr size_t WS_KI = WS_QI + 64 * MiB;
constexpr size_t WS_WI = WS_KI + 2 * MiB;
constexpr size_t WS_PROJ_END = WS_WI + 2 * MiB;
constexpr size_t WS_MIX = WS_XL;
constexpr size_t WS_YL = WS_PROJ_END;
constexpr size_t WS_MERGED = WS_YL + 128 * MiB;
constexpr size_t WS_ACT = WS_MERGED + 128 * MiB;
constexpr size_t WS_HALO = WS_ACT + 344 * MiB;
constexpr size_t WS_WRG = WS_HALO + 44 * MiB;
constexpr size_t WS_SCL = WS_WRG + 1 * MiB;
constexpr size_t WS_SA_H2 = WS_SCL, WS_SB_WFI = WS_SCL + 64 * 1024;
constexpr size_t WS_SB_WIN = WS_SCL + 192 * 1024, WS_SA_H1 = WS_SCL + 256 * 1024;
constexpr size_t WS_END = WS_SCL + 1 * MiB;
constexpr size_t WS_H8 = WS_ACT;
constexpr int WIN_KI_ROW = 0, WIN8_ROW = 256;
constexpr size_t WS_WIN8 = WS_WIN + (size_t)WIN8_ROW * DM * 2;
static_assert(WS_MIX + (size_t)M * DM * 4 <= WS_PROJ_END, "mix overlay");
static_assert(WS_END <= 1536 * MiB, "workspace");
constexpr int CW_BAR = 4096;
constexpr int CW_QUEUE = 192;
constexpr int CW_WMAX_WIN = 8192 + 22016;
constexpr int CW_WMAX_WFI = 8192;
constexpr int CW_CONVQ = 320, CW_CONVQ2 = 384;
constexpr int CW_FLAGS = 64;

constexpr int RING_BYTES = 131072;
constexpr int LDSCTL_OFF = 143488, MISC_OFF = LDSCTL_OFF + 320;
constexpr int LDS_BYTES = 147456;

#define LDS_WAIT() asm volatile("s_waitcnt lgkmcnt(0)" ::: "memory")
#define VM_WAIT() asm volatile("s_waitcnt vmcnt(0)" ::: "memory")

__device__ __forceinline__ unsigned pkh(float lo, float hi) { f16x2 p = {(f16)lo, (f16)hi}; return __builtin_bit_cast(unsigned, p); }
__device__ __forceinline__ unsigned pkb(float lo, float hi) { unsigned r; asm volatile("v_cvt_pk_bf16_f32 %0, %1, %2" : "=v"(r) : "v"(lo), "v"(hi)); return r; }
__device__ __forceinline__ float sat8(float x) { return __builtin_amdgcn_fmed3f(x, -448.0f, 448.0f); }
__device__ __forceinline__ float h2f(u16 u) { return (float)__builtin_bit_cast(f16, u); }
__device__ __forceinline__ float fast_exp(float x) { return __builtin_amdgcn_exp2f(x * 1.4426950408889634f); }
__device__ __forceinline__ float sigmoidf_(float x) { return __builtin_amdgcn_rcpf(1.0f + fast_exp(-x)); }
__device__ __forceinline__ float gelu_tanh(float x) {
    const float t = x * x, p = __builtin_fmaf(t, -0.10294324f, -2.3022082f);
    return x * __builtin_amdgcn_rcpf(1.0f + __builtin_amdgcn_exp2f(x * p));
}
__device__ __forceinline__ f32x4 gelu_tanh4(f32x4 x) {
    const f32x4 t = x * x, p = t * -0.10294324f + -2.3022082f, a = x * p;
    const f32x4 d = (f32x4){__builtin_amdgcn_exp2f(a.x), __builtin_amdgcn_exp2f(a.y), __builtin_amdgcn_exp2f(a.z), __builtin_amdgcn_exp2f(a.w)} + 1.0f;
    return x * (f32x4){__builtin_amdgcn_rcpf(d.x), __builtin_amdgcn_rcpf(d.y), __builtin_amdgcn_rcpf(d.z), __builtin_amdgcn_rcpf(d.w)};
}
__device__ __forceinline__ f32x4 ldb4(const u16* p) { const u32x2 w = *(const u32x2*)p; return (f32x4){__builtin_bit_cast(float, w.x << 16), __builtin_bit_cast(float, w.x & 0xffff0000u), __builtin_bit_cast(float, w.y << 16), __builtin_bit_cast(float, w.y & 0xffff0000u)}; }
__device__ __forceinline__ void ldb8(const u16* p, f32x4& lo, f32x4& hi) { const u32x4 w = *(const u32x4*)p;
    lo = (f32x4){__builtin_bit_cast(float, w.x << 16), __builtin_bit_cast(float, w.x & 0xffff0000u), __builtin_bit_cast(float, w.y << 16), __builtin_bit_cast(float, w.y & 0xffff0000u)};
    hi = (f32x4){__builtin_bit_cast(float, w.z << 16), __builtin_bit_cast(float, w.z & 0xffff0000u), __builtin_bit_cast(float, w.w << 16), __builtin_bit_cast(float, w.w & 0xffff0000u)}; }
__device__ __forceinline__ float wave_sum(float v) {
#pragma unroll
    for (int o = 1; o < 64; o <<= 1) v += __shfl_xor(v, o);
    return v;
}
__device__ __forceinline__ float wave_max(float v) {
#pragma unroll
    for (int o = 1; o < 64; o <<= 1) v = fmaxf(v, __shfl_xor(v, o));
    return v;
}

namespace pg8 {
constexpr int BM = 256, BK = 64, HALF = 128, HTB = HALF * BK * 2, STAGE_BYTES = 8 * HTB, NXCD = 8, WGM = 8;
__host__ __device__ __forceinline__ int lds_byte(int r, int c) { const int st = (r >> 4) * 2 + (c >> 5), rr = r & 15, cc = c & 31, ob = rr * 64 + cc * 2; return st * 1024 + (ob ^ (((ob >> 9) & 1) << 5)); }
__host__ __device__ __forceinline__ void stage_rc(int b, int& R, int& C) { const int st = b / 1024, sb = b % 1024, swz = sb ^ (((sb >> 9) & 1) << 5); R = (st >> 1) * 16 + swz / 64; C = (st & 1) * 32 + (swz % 64) / 2; }
__host__ __device__ __forceinline__ int perm32(int rho) { const int n = rho >> 4, i = rho & 15; return 8 * (i >> 2) + 4 * n + (i & 3); }

struct Unit { int pm, pn; };
struct Gemm { const u16* A; const u16* Bt; int M, N, K; };

struct StaticOrder {
    int nM, nN, nwg, G, c;
    __host__ __device__ void init(int M_, int N_, int G_, int c_) { nM = M_ / BM; nN = N_ / BM; nwg = nM * nN; G = G_; c = c_; }
    __host__ __device__ bool next(int i, Unit& u) const {
        const long L = (long)i * G + c; if (L >= nwg) return false;
        int wgid = (int)L; { const int q = nwg / NXCD, r = nwg % NXCD, xcd = wgid % NXCD, off = wgid / NXCD; wgid = (xcd < r ? xcd * (q + 1) : r * (q + 1) + (xcd - r) * q) + off; }
        const int nig = WGM * nN, gid = wgid / nig, fm = gid * WGM, gsz = (nM - fm) < WGM ? (nM - fm) : WGM;
        u.pm = fm + ((wgid % nig) % gsz); u.pn = (wgid % nig) / gsz; return true;
    }
};

template <class Epi>
__device__ __forceinline__ void gemm_phase(LAS unsigned char* lds, const Gemm g, const StaticOrder& S, const Epi& E) {
    const int tid = threadIdx.x, wid = __builtin_amdgcn_readfirstlane(tid >> 6), lane = tid & 63, wr = wid >> 2, wc = wid & 3, fr = lane & 15, fq = lane >> 4;
    const int K = g.K, nt = K / BK;
    unsigned voffA[2], voffB[2];
#pragma unroll
    for (int i = 0; i < 2; ++i) { int R, C; stage_rc(tid * 16 + i * 8192, R, C); const int Rb = Epi::PERM ? ((R & ~31) + perm32(R & 31)) : R;
        const int Ra = Epi::ROWPERM ? ((((R >> 6) * 16 + (R & 15)) * 8) + ((R >> 4) & 3)) : R;
        voffA[i] = (unsigned)(Ra * K + C) * 2u; voffB[i] = (unsigned)(Rb * K + C) * 2u; }
    const size_t kstep = (size_t)(BK * 2);
    const size_t hstep = (size_t)HALF * K * 2;
    const size_t hstepA = Epi::ROWPERM ? (size_t)4 * K * 2 : hstep;
    const size_t tstep = 2 * hstep;
    const unsigned ldsw = (unsigned)wid * 1024u;
    const int aoff = lds_byte(wr * 64 + fr, fq * 8), boff = lds_byte(wc * 32 + fr, fq * 8);
#define PG8_SA(b, h) (((b) * 2 + (h)) * HTB)
#define PG8_SB(b, h) ((4 + (b) * 2 + (h)) * HTB)
#define PG8_STAGE(bufoff, gbase, voff) do { _Pragma("unroll") for (int _i = 0; _i < 2; ++_i) \
        __builtin_amdgcn_global_load_lds((const unsigned*)((const char*)(gbase) + (voff)[_i]), (LAS unsigned*)(lds + (bufoff) + ldsw + _i * 8192), 16, 0, 0); } while (0)
#define PG8_LDA(dst, b, h) do { _Pragma("unroll") for (int m = 0; m < 4; ++m) { const f16x8 l0_ = *(const LAS f16x8*)(lds + PG8_SA(b, h) + aoff + m * 2048), l1_ = *(const LAS f16x8*)(lds + PG8_SA(b, h) + aoff + m * 2048 + 1024); \
        if constexpr (Epi::MM == 2) dst##8[m] = __builtin_shufflevector(__builtin_bit_cast(i32x4, l0_), __builtin_bit_cast(i32x4, l1_), 0, 1, 2, 3, 4, 5, 6, 7); else { dst[m][0] = l0_; dst[m][1] = l1_; } } } while (0)
#define PG8_LDB(dst, b, h) do { _Pragma("unroll") for (int n = 0; n < 2; ++n) { const f16x8 l0_ = *(const LAS f16x8*)(lds + PG8_SB(b, h) + boff + n * 2048), l1_ = *(const LAS f16x8*)(lds + PG8_SB(b, h) + boff + n * 2048 + 1024); \
        if constexpr (Epi::MM == 2) dst##8[n] = __builtin_shufflevector(__builtin_bit_cast(i32x4, l0_), __builtin_bit_cast(i32x4, l1_), 0, 1, 2, 3, 4, 5, 6, 7); else { dst[n][0] = l0_; dst[n][1] = l1_; } } } while (0)
#define PG8_MMA(ai, bj, At, Bt) do { __builtin_amdgcn_s_setprio(1); _Pragma("unroll") for (int m = 0; m < 4; ++m) _Pragma("unroll") for (int n = 0; n < 2; ++n) { \
        if constexpr (Epi::MM == 2) asm volatile("v_mfma_f32_16x16x128_f8f6f4 %0, %1, %2, %0" : "+v"(acc[ai][bj][m][n]) : "v"(Bt##8[n]), "v"(At##8[m]));     \
        else if constexpr (Epi::MM == 3) { _Pragma("unroll") for (int k = 0; k < 2; ++k) acc[ai][bj][m][n] = __builtin_bit_cast(f32x4, __builtin_amdgcn_mfma_i32_16x16x64_i8(__builtin_bit_cast(i32x4, Bt[n][k]), __builtin_bit_cast(i32x4, At[m][k]), __builtin_bit_cast(i32x4, acc[ai][bj][m][n]), 0, 0, 0)); }     \
        else { _Pragma("unroll") for (int k = 0; k < 2; ++k) acc[ai][bj][m][n] = (Epi::MM == 1) ? __builtin_amdgcn_mfma_f32_16x16x32_bf16(__builtin_bit_cast(s16x8, Bt[n][k]), __builtin_bit_cast(s16x8, At[m][k]), acc[ai][bj][m][n], 0, 0, 0) : __builtin_amdgcn_mfma_f32_16x16x32_f16(Bt[n][k], At[m][k], acc[ai][bj][m][n], 0, 0, 0); } } \
        __builtin_amdgcn_s_setprio(0); } while (0)
#define PG8_WAIT_V(n) asm volatile("s_waitcnt vmcnt(" #n ")" ::: "memory")
#define PG8_WAIT_L(n) asm volatile("s_waitcnt lgkmcnt(" #n ")" ::: "memory")
#define PG8_BAR __builtin_amdgcn_s_barrier()
#define PG8_SCHED __builtin_amdgcn_sched_barrier(0)
    Unit cur, nxt; int ui = 0;
    if (!S.next(0, cur)) return;
    f32x4 acc[2][2][4][2];
#pragma unroll
    for (int a = 0; a < 2; ++a)
#pragma unroll
        for (int b = 0; b < 2; ++b)
#pragma unroll
            for (int m = 0; m < 4; ++m)
#pragma unroll
                for (int n = 0; n < 2; ++n) acc[a][b][m][n] = (f32x4){0.f, 0.f, 0.f, 0.f};
    f16x8 At[4][2], B0[2][2], B1[2][2]; i32x8 At8[4], B08[2], B18[2];
    const char* cA = (const char*)g.A + (size_t)cur.pm * tstep; const char* cB = (const char*)g.Bt + (size_t)cur.pn * tstep;
    if constexpr (Epi::SP2) {
        PG8_STAGE(PG8_SB(0, 0), cB, voffB); PG8_STAGE(PG8_SB(0, 1), cB + hstep, voffB); PG8_STAGE(PG8_SA(0, 0), cA, voffA); PG8_STAGE(PG8_SA(0, 1), cA + hstepA, voffA);
        if (wr == 1) PG8_BAR;
        PG8_WAIT_V(2); PG8_BAR;
        PG8_STAGE(PG8_SB(1, 0), cB + kstep, voffB); PG8_STAGE(PG8_SA(1, 0), cA + kstep, voffA); PG8_STAGE(PG8_SB(1, 1), cB + hstep + kstep, voffB);
        PG8_WAIT_V(6); PG8_BAR;
    } else {
        PG8_STAGE(PG8_SB(0, 0), cB, voffB); PG8_STAGE(PG8_SA(0, 0), cA, voffA); PG8_STAGE(PG8_SB(0, 1), cB + hstep, voffB); PG8_STAGE(PG8_SA(0, 1), cA + hstepA, voffA);
        if (wr == 1) PG8_BAR;
        PG8_WAIT_V(4); PG8_BAR;
        PG8_STAGE(PG8_SB(1, 0), cB + kstep, voffB); PG8_STAGE(PG8_SA(1, 0), cA + kstep, voffA); PG8_STAGE(PG8_SB(1, 1), cB + hstep + kstep, voffB);
        PG8_WAIT_V(6); PG8_BAR;
    }
    for (;;) {
        const bool has_next = S.next(ui + 1, nxt);
        const char* nA = has_next ? (const char*)g.A + (size_t)nxt.pm * tstep : cA; const char* nB = has_next ? (const char*)g.Bt + (size_t)nxt.pn * tstep : cB;
        for (int t = 0; t < nt; t += 2) {
            const bool last = (t == nt - 2);
            const char* a1 = cA + (size_t)(t + 1) * kstep;
            const char* a2 = last ? nA : cA + (size_t)(t + 2) * kstep; const char* b2 = last ? nB : cB + (size_t)(t + 2) * kstep;
            const char* a3 = a2 + kstep; const char* b3 = b2 + kstep;
            if constexpr (Epi::SP2) {
            PG8_LDB(B0, 0, 0); PG8_LDB(B1, 0, 1); PG8_SCHED; PG8_LDA(At, 0, 0); PG8_STAGE(PG8_SA(1, 1), a1 + hstepA, voffA);
            PG8_WAIT_V(8); PG8_WAIT_L(0); PG8_BAR; PG8_MMA(0, 0, At, B0); PG8_MMA(0, 1, At, B1); PG8_BAR; PG8_SCHED;
            PG8_LDA(At, 0, 1); PG8_STAGE(PG8_SB(0, 0), b2, voffB); PG8_STAGE(PG8_SB(0, 1), b2 + hstep, voffB); PG8_STAGE(PG8_SA(0, 0), a2, voffA);
            PG8_WAIT_V(8); PG8_WAIT_L(0); PG8_BAR; PG8_MMA(1, 0, At, B0); PG8_MMA(1, 1, At, B1); PG8_BAR; PG8_SCHED;
            PG8_LDB(B0, 1, 0); PG8_LDB(B1, 1, 1); PG8_SCHED; PG8_LDA(At, 1, 0); PG8_STAGE(PG8_SA(0, 1), a2 + hstepA, voffA);
            PG8_WAIT_V(8); PG8_WAIT_L(0); PG8_BAR; PG8_MMA(0, 0, At, B0); PG8_MMA(0, 1, At, B1); PG8_BAR; PG8_SCHED;
            PG8_LDA(At, 1, 1); PG8_STAGE(PG8_SB(1, 0), b3, voffB); PG8_STAGE(PG8_SB(1, 1), b3 + hstep, voffB); PG8_STAGE(PG8_SA(1, 0), a3, voffA);
            PG8_WAIT_V(8); PG8_WAIT_L(0); PG8_BAR; PG8_MMA(1, 0, At, B0); PG8_MMA(1, 1, At, B1); PG8_BAR; PG8_SCHED;
                    } else {
            PG8_LDB(B0, 0, 0); PG8_SCHED; PG8_LDA(At, 0, 0); PG8_STAGE(PG8_SA(1, 1), a1 + hstepA, voffA);
            PG8_WAIT_L(8); PG8_BAR; PG8_WAIT_L(0); PG8_MMA(0, 0, At, B0); PG8_BAR; PG8_SCHED;
            PG8_LDB(B1, 0, 1); PG8_STAGE(PG8_SB(0, 0), b2, voffB);
            PG8_BAR; PG8_WAIT_L(0); PG8_MMA(0, 1, At, B1); PG8_BAR;
            PG8_LDA(At, 0, 1); PG8_STAGE(PG8_SA(0, 0), a2, voffA);
            PG8_BAR; PG8_WAIT_L(0); PG8_MMA(1, 0, At, B0); PG8_BAR; PG8_SCHED;
            PG8_STAGE(PG8_SB(0, 1), b2 + hstep, voffB);
            PG8_WAIT_V(6); PG8_BAR; PG8_MMA(1, 1, At, B1); PG8_BAR;
            PG8_LDB(B0, 1, 0); PG8_SCHED; PG8_LDA(At, 1, 0); PG8_STAGE(PG8_SA(0, 1), a2 + hstepA, voffA);
            PG8_WAIT_L(8); PG8_BAR; PG8_WAIT_L(0); PG8_MMA(0, 0, At, B0); PG8_BAR; PG8_SCHED;
            PG8_LDB(B1, 1, 1); PG8_STAGE(PG8_SB(1, 0), b3, voffB);
            PG8_BAR; PG8_WAIT_L(0); PG8_MMA(0, 1, At, B1); PG8_BAR;
            PG8_LDA(At, 1, 1); PG8_STAGE(PG8_SA(1, 0), a3, voffA);
            PG8_BAR; PG8_WAIT_L(0); PG8_MMA(1, 0, At, B0); PG8_BAR; PG8_SCHED;
            PG8_STAGE(PG8_SB(1, 1), b3 + hstep, voffB);
            PG8_WAIT_V(6); PG8_BAR; PG8_MMA(1, 1, At, B1); PG8_BAR;
            }
        }
        if (wr == 0) PG8_BAR;
        if constexpr (Epi::MM == 2) asm volatile("s_nop 15\n\ts_nop 15" ::: "memory");
        E(acc, cur, wr, wc, fr, fq);
        if (!has_next) break;
#pragma unroll
        for (int a = 0; a < 2; ++a)
#pragma unroll
            for (int b = 0; b < 2; ++b)
#pragma unroll
                for (int m = 0; m < 4; ++m)
#pragma unroll
                    for (int n = 0; n < 2; ++n) acc[a][b][m][n] = (f32x4){0.f, 0.f, 0.f, 0.f};
        cur = nxt; cA = nA; cB = nB; ++ui;
        if (wr == 1) PG8_BAR;
    }
    PG8_WAIT_V(0);
    PG8_BAR;
#undef PG8_SA
#undef PG8_SB
#undef PG8_STAGE
#undef PG8_LDA
#undef PG8_LDB
#undef PG8_MMA
#undef PG8_WAIT_V
#undef PG8_WAIT_L
#undef PG8_BAR
#undef PG8_SCHED
}

struct EpiF32 {
    static constexpr bool PERM = false, ROWPERM = false, SP2 = true; static constexpr int MM = 1;
    float* C; int ldc;
    __device__ __forceinline__ void operator()(const f32x4 (&acc)[2][2][4][2], const Unit& u, int wr, int wc, int fr, int fq) const {
        const int row0 = u.pm * BM + wr * 64 + fr, col0 = u.pn * BM + wc * 32 + 4 * fq;
#pragma unroll
        for (int ai = 0; ai < 2; ++ai)
#pragma unroll
            for (int m = 0; m < 4; ++m) { float* rowp = C + (size_t)(row0 + ai * HALF + m * 16) * ldc + col0;
#pragma unroll
                for (int bj = 0; bj < 2; ++bj)
#pragma unroll
                    for (int n = 0; n < 2; ++n) *(f32x4*)(rowp + bj * HALF + n * 16) = acc[ai][bj][m][n]; }
    }
};
struct EpiB16 {
    static constexpr bool PERM = true, ROWPERM = false, SP2 = true; static constexpr int MM = 1;
    u16* C; int ldc;
    __device__ __forceinline__ void operator()(const f32x4 (&acc)[2][2][4][2], const Unit& u, int wr, int wc, int fr, int fq) const {
        const int row0 = u.pm * BM + wr * 64 + fr, col0 = u.pn * BM + wc * 32 + 8 * fq;
#pragma unroll
        for (int ai = 0; ai < 2; ++ai)
#pragma unroll
            for (int m = 0; m < 4; ++m) { u16* rowp = C + (size_t)(row0 + ai * HALF + m * 16) * ldc + col0;
#pragma unroll
                for (int bj = 0; bj < 2; ++bj) { const f32x4 v0 = acc[ai][bj][m][0], v1 = acc[ai][bj][m][1];
                    u32x4 w; w.x = pkb(v0.x, v0.y); w.y = pkb(v0.z, v0.w); w.z = pkb(v1.x, v1.y); w.w = pkb(v1.z, v1.w);
                    *(u32x4*)(rowp + bj * HALF) = w; } }
    }
};
struct EpiB16S8 {
    static constexpr bool PERM = true, ROWPERM = false, SP2 = true; static constexpr int MM = 2;
    u16* C; int ldc;
    __device__ __forceinline__ void operator()(const f32x4 (&acc)[2][2][4][2], const Unit& u, int wr, int wc, int fr, int fq) const {
        const int row0 = u.pm * BM + wr * 64 + fr, col0 = u.pn * BM + wc * 32 + 8 * fq; const float sc = 1.0f / 2048.0f;
#pragma unroll
        for (int ai = 0; ai < 2; ++ai)
#pragma unroll
            for (int m = 0; m < 4; ++m) { u16* rowp = C + (size_t)(row0 + ai * HALF + m * 16) * ldc + col0;
#pragma unroll
                for (int bj = 0; bj < 2; ++bj) { const f32x4 v0 = acc[ai][bj][m][0] * sc, v1 = acc[ai][bj][m][1] * sc;
                    u32x4 w; w.x = pkb(v0.x, v0.y); w.y = pkb(v0.z, v0.w); w.z = pkb(v1.x, v1.y); w.w = pkb(v1.z, v1.w);
                    *(u32x4*)(rowp + bj * HALF) = w; } }
    }
};
struct EpiB16F8 {
    static constexpr bool PERM = true, ROWPERM = false, SP2 = true; static constexpr int MM = 2;
    u16* C; int ldc;
    __device__ __forceinline__ void operator()(const f32x4 (&acc)[2][2][4][2], const Unit& u, int wr, int wc, int fr, int fq) const {
        const int row0 = u.pm * BM + wr * 64 + fr, col0 = u.pn * BM + wc * 32 + 8 * fq;
#pragma unroll
        for (int ai = 0; ai < 2; ++ai)
#pragma unroll
            for (int m = 0; m < 4; ++m) { u16* rowp = C + (size_t)(row0 + ai * HALF + m * 16) * ldc + col0;
#pragma unroll
                for (int bj = 0; bj < 2; ++bj) { const f32x4 v0 = acc[ai][bj][m][0], v1 = acc[ai][bj][m][1];
                    u32x4 w; w.x = pkb(v0.x, v0.y); w.y = pkb(v0.z, v0.w); w.z = pkb(v1.x, v1.y); w.w = pkb(v1.z, v1.w);
                    *(u32x4*)(rowp + bj * HALF) = w; } }
    }
};
struct EpiProj {
    static constexpr bool PERM = true, ROWPERM = false, SP2 = true; static constexpr int MM = 0;
    unsigned char* ws;
    __device__ __forceinline__ void operator()(const f32x4 (&acc)[2][2][4][2], const Unit& u, int wr, int wc, int fr, int fq) const {
        const int row0 = u.pm * BM + wr * 64 + fr; const int pn = u.pn;
        u16* base = (u16*)(ws + WS_QI); const int ldc = NIH * IDIM, colt = pn * 256;
        const int col0 = colt + wc * 32 + 8 * fq;
#pragma unroll
        for (int ai = 0; ai < 2; ++ai)
#pragma unroll
            for (int m = 0; m < 4; ++m) { u16* rowp = base + (size_t)(row0 + ai * HALF + m * 16) * ldc + col0;
#pragma unroll
                for (int bj = 0; bj < 2; ++bj) { const f32x4 v0 = acc[ai][bj][m][0], v1 = acc[ai][bj][m][1];
                    u32x4 w; w.x = pkh(v0[0], v0[1]); w.y = pkh(v0[2], v0[3]); w.z = pkh(v1[0], v1[1]); w.w = pkh(v1[2], v1[3]);
                    *(u32x4*)(rowp + bj * HALF) = w; } }
    }
};
__device__ __forceinline__ unsigned cvt2_fp8(float a, float b) { unsigned r; asm("v_cvt_pk_fp8_f32 %0, %1, %2" : "=v"(r) : "v"(a), "v"(b)); return r; }
struct EpiProjQ {
    static constexpr bool PERM = true, ROWPERM = false, SP2 = true; static constexpr int MM = 3;
    unsigned char* ws; const float* sa; const float* sb;
    __device__ __forceinline__ void operator()(const f32x4 (&acc)[2][2][4][2], const Unit& u, int wr, int wc, int fr, int fq) const {
        const int row0 = u.pm * BM + wr * 64 + fr; const int pn = u.pn;
        const float* sbp = sb + pn * 256 + wc * 32 + 8 * fq;
        const f32x4 sbv[2][2] = {{*(const f32x4*)(sbp), *(const f32x4*)(sbp + 4)}, {*(const f32x4*)(sbp + HALF), *(const f32x4*)(sbp + HALF + 4)}};
        float rsa[8];
#pragma unroll
        for (int q = 0; q < 8; ++q) rsa[q] = sa[row0 + (q >> 2) * HALF + (q & 3) * 16];
#define PRJ_V(ai_, bj_, m_, n_, rs_) ({ const i32x4 t_ = __builtin_bit_cast(i32x4, acc[ai_][bj_][m_][n_]); const int t0_ = t_.x, t1_ = t_.y, t2_ = t_.z, t3_ = t_.w; (f32x4){(float)t0_, (float)t1_, (float)t2_, (float)t3_} * sbv[bj_][n_] * (rs_); })
        if (pn < 16 || pn >= 28) {
            u16* base = (u16*)(ws + (pn < 8 ? WS_XL : pn < 16 ? WS_GATE : WS_QI)); const int col0 = (pn < 28 ? (pn & 7) : (pn - 28)) * 256 + wc * 32 + 8 * fq;
#pragma unroll
            for (int ai = 0; ai < 2; ++ai)
#pragma unroll
                for (int m = 0; m < 4; ++m) { const int row = row0 + ai * HALF + m * 16; u16* rowp = base + (size_t)row * DATT + col0; const float rs = rsa[4 * ai + m];
#pragma unroll
                    for (int bj = 0; bj < 2; ++bj) { const f32x4 v0 = PRJ_V(ai, bj, m, 0, rs), v1 = PRJ_V(ai, bj, m, 1, rs);
                        u32x4 w; w.x = pkh(v0[0], v0[1]); w.y = pkh(v0[2], v0[3]); w.z = pkh(v1[0], v1[1]); w.w = pkh(v1[2], v1[3]);
                        *(u32x4*)(rowp + bj * HALF) = w; } }
        } else {
            unsigned char* b8 = ws + (pn < 24 ? WS_Q : pn < 26 ? WS_K : WS_V); const int c8 = (pn < 24 ? (pn - 16) : (pn & 1)) * 256 + wc * 32 + 8 * fq; const int pitch = pn < 24 ? DATT : DKV;
#pragma unroll
            for (int ai = 0; ai < 2; ++ai)
#pragma unroll
                for (int m = 0; m < 4; ++m) { const int row = row0 + ai * HALF + m * 16; const float rs = 8.0f * rsa[4 * ai + m];
#pragma unroll
                    for (int bj = 0; bj < 2; ++bj) { const f32x4 v0 = PRJ_V(ai, bj, m, 0, rs), v1 = PRJ_V(ai, bj, m, 1, rs);
                        u32x2 w; w.x = (cvt2_fp8(sat8(v0.x), sat8(v0.y)) & 0xffffu) | (cvt2_fp8(sat8(v0.z), sat8(v0.w)) << 16); w.y = (cvt2_fp8(sat8(v1.x), sat8(v1.y)) & 0xffffu) | (cvt2_fp8(sat8(v1.z), sat8(v1.w)) << 16);
                        *(u32x2*)(b8 + (size_t)row * pitch + c8 + bj * HALF) = w; } }
        }
#undef PRJ_V
    }
};
__device__ __forceinline__ float dpp_shr1f(float x) { return __builtin_bit_cast(float, __builtin_amdgcn_update_dpp(0, __builtin_bit_cast(int, x), 0x111, 0xf, 0xf, false)); }
__device__ __forceinline__ f32x4 dpp_shr1(f32x4 v) {
    f32x4 r; r.x = dpp_shr1f(v.x); r.y = dpp_shr1f(v.y); r.z = dpp_shr1f(v.z); r.w = dpp_shr1f(v.w);
    return r;
}
struct EpiFfn {
    static constexpr bool PERM = true, ROWPERM = true, SP2 = true; static constexpr int MM = 3;
    u16* act; float* halo; const float* cw; const float* cb; const float* sa; const float* sb;
    __device__ __forceinline__ void operator()(const f32x4 (&acc)[2][2][4][2], const Unit& u, int wr, int wc, int fr, int fq) const {
        const int L = wr * 16 + fr, tok0 = u.pm * BM + 8 * L, run = 2 * u.pm + wr;
        const int f0 = u.pn * 128 + wc * 32 + 8 * fq;
        const f32x4 saL = *(const f32x4*)(sa + tok0), saH = *(const f32x4*)(sa + tok0 + 4);
        const float sap[8] = {saL.x, saL.y, saL.z, saL.w, saH.x, saH.y, saH.z, saH.w};
#define FFN_V(ai_, bj_, m_) ({ const i32x4 t_ = __builtin_bit_cast(i32x4, acc[ai_][bj_][m_][n]); const int t0_ = t_.x, t1_ = t_.y, t2_ = t_.z, t3_ = t_.w; (f32x4){(float)t0_, (float)t1_, (float)t2_, (float)t3_} * sap[4 * (ai_) + (m_)]; })
        u32x2 p0[8];
#pragma unroll
        for (int n = 0; n < 2; ++n) {
            const int fg = f0 + 4 * n, fu = DFF + fg;
            const f32x4 sg = *(const f32x4*)(sb + u.pn * 256 + wc * 32 + 8 * fq + 4 * n), su = *(const f32x4*)(sb + u.pn * 256 + 128 + wc * 32 + 8 * fq + 4 * n);
            const f32x4 g0 = *(const f32x4*)(cw + fg) * sg, g1 = *(const f32x4*)(cw + DFF2 + fg) * sg, g2 = *(const f32x4*)(cw + 2 * DFF2 + fg) * sg, gb = *(const f32x4*)(cb + fg);
            const f32x4 su2 = su * 2.0f; const f32x4 u0 = *(const f32x4*)(cw + fu) * su2, u1 = *(const f32x4*)(cw + DFF2 + fu) * su2, u2 = *(const f32x4*)(cw + 2 * DFF2 + fu) * su2, ub = *(const f32x4*)(cb + fu) * 2.0f;
            f32x4 gm2 = dpp_shr1(FFN_V(1, 0, 2)), gm1 = dpp_shr1(FFN_V(1, 0, 3)), um2 = dpp_shr1(FFN_V(1, 1, 2)), um1 = dpp_shr1(FFN_V(1, 1, 3));
            if (fr == 0) { float* hp = halo + (size_t)run * 4 * DFF2;
                *(f32x4*)(hp + fg) = FFN_V(0, 0, 0) * sg; *(f32x4*)(hp + DFF2 + fg) = FFN_V(0, 0, 1) * sg; *(f32x4*)(hp + fu) = FFN_V(0, 1, 0) * su; *(f32x4*)(hp + DFF2 + fu) = FFN_V(0, 1, 1) * su; }
            if (fr == 15) { float* hp = halo + ((size_t)run * 4 + 2) * DFF2;
                *(f32x4*)(hp + fg) = FFN_V(1, 0, 2) * sg; *(f32x4*)(hp + DFF2 + fg) = FFN_V(1, 0, 3) * sg; *(f32x4*)(hp + fu) = FFN_V(1, 1, 2) * su; *(f32x4*)(hp + DFF2 + fu) = FFN_V(1, 1, 3) * su; }
#pragma unroll
            for (int j = 0; j < 8; ++j) {
                const f32x4 pg = FFN_V(j >> 2, 0, j & 3), pu = FFN_V(j >> 2, 1, j & 3);
                const f32x4 ug = gb + g0 * gm2 + g1 * gm1 + g2 * pg, uu = ub + u0 * um2 + u1 * um1 + u2 * pu;
                gm2 = gm1; gm1 = pg; um2 = um1; um1 = pu;
                const f32x4 av = gelu_tanh4(ug) * uu; u32x2 pk; pk.x = cvt2_fp8(sat8(av.x), sat8(av.y)); pk.y = cvt2_fp8(sat8(av.z), sat8(av.w));
                if (n == 0) p0[j] = pk;
                else if (j >= 2 || fr != 0) { u32x2 w; w.x = (p0[j].x & 0xffffu) | (p0[j].y << 16); w.y = (pk.x & 0xffffu) | (pk.y << 16); *(u32x2*)((unsigned char*)act + (size_t)(tok0 + j) * DFF + f0) = w; }
            }
        }
#undef FFN_V
    }
};
}

#define XB_TMO      128
#define XB_XCNT(j)  (256  + 64 * (j))
#define XB_XSUB(j)  (1280 + 64 * (j))
#define XB_XGEN(j)  (2304 + 64 * (j))
#define XB_TOP      3328
#define XB_TOPGEN   3392
#define XCD_BAR_WORDS 3456
#define XB_SPIN_CAP (1u << 22)
__device__ __forceinline__ unsigned xb_ld(unsigned* p)              { return __hip_atomic_load(p, __ATOMIC_RELAXED, __HIP_MEMORY_SCOPE_AGENT); }
__device__ __forceinline__ unsigned xb_add(unsigned* p, unsigned v) { return __hip_atomic_fetch_add(p, v, __ATOMIC_RELAXED, __HIP_MEMORY_SCOPE_AGENT); }
__device__ __forceinline__ unsigned xb_xcc_id() { return (unsigned)__builtin_amdgcn_s_getreg((3 << 11) | 20) & 0xFu; }
#define XB_SPIN(cond, bar) do { unsigned _sp = 0; while (cond) { __builtin_amdgcn_s_sleep(1); \
    if ((++_sp & 255u) == 0u) { if (xb_ld(&(bar)[XB_TMO])) break; if (_sp > XB_SPIN_CAP) { atomicAdd(&(bar)[XB_TMO], 1u); break; } } } } while (0)
struct XcdBarrier { unsigned* bar; unsigned x; volatile LAS unsigned* st; };
__device__ __forceinline__ XcdBarrier xcd_barrier_post(unsigned* bar, volatile LAS unsigned* st) {
    XcdBarrier b; b.bar = bar; b.x = xb_xcc_id(); b.st = st;
    if (threadIdx.x == 0) (void)xb_add(&bar[XB_XCNT(b.x)], 1u);
    return b;
}
__device__ __forceinline__ void xcd_barrier_complete(unsigned* bar, unsigned x, unsigned& nloc, unsigned& nx) {
    const unsigned G = gridDim.x * gridDim.y * gridDim.z;
    unsigned sum, cnt, mine, sp = 0u;
    for (;;) {
        sum = 0u; cnt = 0u; mine = 0u;
#pragma unroll
        for (unsigned j = 0; j < 16; ++j) { const unsigned c = xb_ld(&bar[XB_XCNT(j)]); sum += c; cnt += (c > 0u) ? 1u : 0u; mine = (j == x) ? c : mine; }
        if (sum == G) break;
        __builtin_amdgcn_s_sleep(1);
        if ((++sp & 255u) == 0u) { if (xb_ld(&bar[XB_TMO])) break; if (sp > XB_SPIN_CAP) { atomicAdd(&bar[XB_TMO], 1u); break; } }
    }
    nloc = mine > 0u ? mine : 1u; nx = cnt > 0u ? cnt : 1u;
}
__device__ __forceinline__ void xcd_barrier(const XcdBarrier& b) {
    asm volatile("s_waitcnt vmcnt(0)" ::: "memory");
    __syncthreads();
    if (threadIdx.x == 0) {
        unsigned* bar = b.bar;
        __builtin_amdgcn_s_waitcnt(0);
        unsigned nloc = b.st[0], nx = b.st[1];
        if (nloc == 0u) { xcd_barrier_complete(bar, b.x, nloc, nx); b.st[0] = nloc; b.st[1] = nx; }
        const unsigned old = xb_add(&bar[XB_XSUB(b.x)], 1u);
        const unsigned gen = old / nloc;
        if (old + 1u == (gen + 1u) * nloc) {
            __builtin_amdgcn_fence(__ATOMIC_RELEASE, "agent");
            asm volatile("s_waitcnt vmcnt(0)" ::: "memory");
            const unsigned og = xb_add(&bar[XB_TOP], 1u);
            const unsigned tg = og / nx;
            if (og + 1u == (tg + 1u) * nx) xb_add(&bar[XB_TOPGEN], 1u);
            else XB_SPIN(xb_ld(&bar[XB_TOPGEN]) == tg, bar);
            __builtin_amdgcn_fence(__ATOMIC_ACQUIRE, "agent");
            xb_add(&bar[XB_XGEN(b.x)], 1u);
            asm volatile("s_waitcnt vmcnt(0)" ::: "memory");
        } else {
            XB_SPIN(xb_ld(&bar[XB_XGEN(b.x)]) == gen, bar);
            __builtin_amdgcn_fence(__ATOMIC_ACQUIRE, "agent");
            asm volatile("s_waitcnt vmcnt(0)" ::: "memory");
        }
    }
    __syncthreads();
}

struct Frame {
    LAS unsigned char* lds;
    unsigned char* ws;
    int tid, lane, wave, G, bid;
    const float* const __attribute__((address_space(4)))* kin; float* out;
    __device__ __forceinline__ const float* inp(int i) const { return kin[i]; }
};
enum { I_X = 0, I_C, I_WADA, I_BADA, I_GPREMIX, I_GPOSTMIX, I_GPREFFN, I_GPOSTFFN, I_WIN, I_CLW, I_CLB, I_WRA, I_BRA, I_WRX, I_BRX, I_LAM, I_GLRU, I_GATTN, I_WOUT, I_WFI, I_CFW, I_CFB, I_WFO };

template <int MODE> __device__ __forceinline__ void p0_transpose_item(const float* W, int K, int N, u16* WT, int dest_row0, LAS float* scr, int k0, int n0, int lane) {
#pragma unroll 8
    for (int i = 0; i < 32; ++i) { const int kk = 2 * i + (lane >> 5); scr[kk * 33 + (lane & 31)] = W[(size_t)(k0 + kk) * N + n0 + (lane & 31)]; }
    LDS_WAIT(); asm volatile("" ::: "memory");
    const int c = lane & 7;
#pragma unroll
    for (int j = 0; j < 4; ++j) { const int n = (lane >> 3) + 8 * j; const LAS float* s = scr + (8 * c) * 33 + n;
        if (MODE == 2) { int lo = __builtin_amdgcn_cvt_pk_fp8_f32(sat8(256.0f * s[0 * 33]), sat8(256.0f * s[1 * 33]), 0, false); lo = __builtin_amdgcn_cvt_pk_fp8_f32(sat8(256.0f * s[2 * 33]), sat8(256.0f * s[3 * 33]), lo, true);
            int hi = __builtin_amdgcn_cvt_pk_fp8_f32(sat8(256.0f * s[4 * 33]), sat8(256.0f * s[5 * 33]), 0, false); hi = __builtin_amdgcn_cvt_pk_fp8_f32(sat8(256.0f * s[6 * 33]), sat8(256.0f * s[7 * 33]), hi, true);
            u32x2 o8; o8.x = (unsigned)lo; o8.y = (unsigned)hi; *(u32x2*)((unsigned char*)WT + (size_t)(dest_row0 + n) * K + k0 + 8 * c) = o8; }
        else { u32x4 o; if (MODE == 1) { o.x = pkb(s[0 * 33], s[1 * 33]); o.y = pkb(s[2 * 33], s[3 * 33]); o.z = pkb(s[4 * 33], s[5 * 33]); o.w = pkb(s[6 * 33], s[7 * 33]); }
            else { o.x = pkh(s[0 * 33], s[1 * 33]); o.y = pkh(s[2 * 33], s[3 * 33]); o.z = pkh(s[4 * 33], s[5 * 33]); o.w = pkh(s[6 * 33], s[7 * 33]); }
            *(u32x4*)(WT + (size_t)(dest_row0 + n) * K + k0 + 8 * c) = o; } }
    LDS_WAIT(); asm volatile("" ::: "memory");
}
__device__ __forceinline__ void p0_phase(Frame& F) {
    {
        LAS float* scl = (LAS float*)F.lds;
        LAS float* red = (LAS float*)(F.lds + 65536);
        const float* c = F.inp(I_C);
        for (int i = F.tid; i < BATCH * DM; i += NTHR) { const float v = c[i]; scl[i] = v / (1.0f + expf(-v)); }
        __syncthreads();
        float* mod = (float*)(F.ws + WS_MOD);
        const int cq = F.tid % 24, kl = F.tid / 24;
        for (int cb = F.bid; cb < NMOD / 96; cb += F.G) {
            if (kl < 16) {
                const float* wp = F.inp(I_WADA) + (size_t)kl * NMOD + 96 * cb + 4 * cq;
                f32x4 a0 = {0, 0, 0, 0}, a1 = a0, a2 = a0, a3 = a0;
#pragma unroll 8
                for (int i = 0; i < DM / 16; ++i) {
                    const f32x4 w = *(const f32x4*)(wp + (size_t)i * 16 * NMOD); const int k = kl + 16 * i;
                    a0 += w * scl[k]; a1 += w * scl[DM + k]; a2 += w * scl[2 * DM + k]; a3 += w * scl[3 * DM + k];
                }
                *(LAS f32x4*)(red + (kl * 4 + 0) * 96 + 4 * cq) = a0; *(LAS f32x4*)(red + (kl * 4 + 1) * 96 + 4 * cq) = a1;
                *(LAS f32x4*)(red + (kl * 4 + 2) * 96 + 4 * cq) = a2; *(LAS f32x4*)(red + (kl * 4 + 3) * 96 + 4 * cq) = a3;
            }
            __syncthreads();
            if (F.tid < 384) { const int b = F.tid / 96, col = F.tid % 96; float s = 0.f;
#pragma unroll
                for (int k = 0; k < 16; ++k) s += red[(k * 4 + b) * 96 + col];
                mod[b * NMOD + 96 * cb + col] = s + F.inp(I_BADA)[96 * cb + col]; }
            __syncthreads();
        }
    }
    {
        LAS float* scr = (LAS float*)(F.lds + F.wave * 16384);
        const int gw = F.bid * NWAVES + F.wave, NGW = F.G * NWAVES;
        constexpr int I_1 = (DM / 64) * (DIN / 32);
        for (int it = gw; it < I_1; it += NGW) { const int nblk = DIN / 32, kb = it / nblk, nb = it % nblk;
            if (nb >= 288) p0_transpose_item<0>(F.inp(I_WIN), DM, DIN, (u16*)(F.ws + WS_WIN), 32 * (nb - 288), scr, 64 * kb, 32 * nb, F.lane); }
        { u16* WT = (u16*)(F.ws + WS_WRG);
          for (int e = F.bid * NTHR + F.tid; e < NLB * 256 * LB; e += F.G * NTHR) { const int i = e & 127, o = (e >> 7) & 255, nb = e >> 15;
              const float* W = (o < 128) ? F.inp(I_WRA) : F.inp(I_WRX);
              WT[e] = __builtin_bit_cast(u16, (f16)W[((size_t)nb * LB + i) * LB + (o & 127)]); } }
    }
}

__device__ __forceinline__ void p1_phase(Frame& F) {
    const float* mod = (const float*)(F.ws + WS_MOD); u16* H = (u16*)(F.ws + WS_H);
    LAS f32x4* va = (LAS f32x4*)F.lds; LAS f32x4* vb = va + DM / 4;
    for (int blk = F.bid; blk < M / 64; blk += F.G) {
        const int b = (blk * 64) / SEQ;
        __syncthreads();
        for (int i = F.tid; i < DM / 4; i += NTHR) { va[i] = ((const f32x4*)F.inp(I_GPREMIX))[i] * (1.0f + ((const f32x4*)(mod + b * NMOD + DM))[i]); vb[i] = ((const f32x4*)(mod + b * NMOD))[i]; }
        __syncthreads();
        const int row0 = blk * 64 + F.wave * 8;
        f32x4 nx[16];
#pragma unroll
        for (int j = 0; j < 16; ++j) nx[j] = ((const f32x4*)(F.inp(I_X) + (size_t)row0 * DM) + F.lane)[64 * j];
#pragma unroll 1
        for (int ri = 0; ri < 8; ++ri) {
            const int row = row0 + ri;
            f32x4 v[16]; float s = 0.f;
#pragma unroll
            for (int j = 0; j < 16; ++j) { v[j] = nx[j]; s += (v[j].x * v[j].x + v[j].y * v[j].y) + (v[j].z * v[j].z + v[j].w * v[j].w); }
            if (ri < 7) {
#pragma unroll
                for (int j = 0; j < 16; ++j) nx[j] = ((const f32x4*)(F.inp(I_X) + (size_t)(row + 1) * DM) + F.lane)[64 * j]; }
            const float rstd = 1.0f / sqrtf(wave_sum(s) * (1.0f / DM) + RMS_EPS);
            u32x2* o = (u32x2*)(H + (size_t)row * DM) + F.lane; unsigned* o8 = (unsigned*)(F.ws + WS_H8 + (size_t)row * DM) + F.lane;
            float am = 0.f;
#pragma unroll
            for (int j = 0; j < 16; ++j) { const f32x4 y = v[j] * rstd * va[F.lane + 64 * j] + vb[F.lane + 64 * j]; u32x2 w; w.x = pkh(y.x, y.y); w.y = pkh(y.z, y.w); o[64 * j] = w;
                am = fmaxf(fmaxf(am, fmaxf(fabsf(y.x), fabsf(y.y))), fmaxf(fabsf(y.z), fabsf(y.w))); }
#pragma unroll
            for (int off = 32; off >= 1; off >>= 1) am = fmaxf(am, __shfl_xor(am, off));
            const float qs = am > 0.f ? am * (1.0f / 127.0f) : 1.0f, qi = 1.0f / qs;
            if (F.lane == 0) ((float*)(F.ws + WS_SA_H1))[row] = qs;
#pragma unroll
            for (int j = 0; j < 16; ++j) { if ((j & 3) == 0) __builtin_amdgcn_sched_barrier(0);
                const f32x4 y = (v[j] * rstd * va[F.lane + 64 * j] + vb[F.lane + 64 * j]) * qi;
                const int q0 = __float2int_rn(y.x), q1 = __float2int_rn(y.y), q2 = __float2int_rn(y.z), q3 = __float2int_rn(y.w);
                o8[64 * j] = (unsigned)(q0 & 255) | ((unsigned)(q1 & 255) << 8) | ((unsigned)(q2 & 255) << 16) | ((unsigned)q3 << 24); }
        }
    }
}

template <int MODE> __device__ __forceinline__ void lc_transpose_item(const float* W, int K, int N, u16* WT, int dest_row0, LAS float* scr, int k0, int n0, int lane) {
    float t[32];
    const float* wp = W + (size_t)(k0 + (lane >> 5)) * N + n0 + (lane & 31);
#pragma unroll
    for (int i = 0; i < 32; ++i) t[i] = wp[(size_t)(2 * i) * N];
#pragma unroll
    for (int i = 0; i < 32; ++i) scr[(2 * i + (lane >> 5)) * 33 + (lane & 31)] = t[i];
    LDS_WAIT(); asm volatile("" ::: "memory");
    const int c = lane & 7;
#pragma unroll
    for (int j = 0; j < 4; ++j) { const int n = (lane >> 3) + 8 * j; const LAS float* s = scr + (8 * c) * 33 + n;
        if (MODE == 2) { int lo = __builtin_amdgcn_cvt_pk_fp8_f32(sat8(256.0f * s[0 * 33]), sat8(256.0f * s[1 * 33]), 0, false); lo = __builtin_amdgcn_cvt_pk_fp8_f32(sat8(256.0f * s[2 * 33]), sat8(256.0f * s[3 * 33]), lo, true);
            int hi = __builtin_amdgcn_cvt_pk_fp8_f32(sat8(256.0f * s[4 * 33]), sat8(256.0f * s[5 * 33]), 0, false); hi = __builtin_amdgcn_cvt_pk_fp8_f32(sat8(256.0f * s[6 * 33]), sat8(256.0f * s[7 * 33]), hi, true);
            u32x2 o8; o8.x = (unsigned)lo; o8.y = (unsigned)hi; *(u32x2*)((unsigned char*)WT + (size_t)(dest_row0 + n) * K + k0 + 8 * c) = o8; }
        else { u32x4 o; o.x = pkb(s[0 * 33], s[1 * 33]); o.y = pkb(s[2 * 33], s[3 * 33]); o.z = pkb(s[4 * 33], s[5 * 33]); o.w = pkb(s[6 * 33], s[7 * 33]);
            *(u32x4*)(WT + (size_t)(dest_row0 + n) * K + k0 + 8 * c) = o; } }
    LDS_WAIT(); asm volatile("" ::: "memory");
}
template <int Q> __device__ __forceinline__ void late_convert(Frame& F) {
    LAS float* scr = (LAS float*)(F.lds + F.wave * 16384);
    unsigned* q = (unsigned*)(F.ws + WS_CTL) + (Q == 0 ? CW_CONVQ : CW_CONVQ2);
    constexpr int I_2 = (DM / 64) * (DM / 32), I_4 = (DFF / 64) * (DM / 32), NL = Q == 0 ? I_2 : I_4, CH = 8, KD = Q == 0 ? DM : DFF;
    const float* W = Q == 0 ? F.inp(I_WOUT) : F.inp(I_WFO); unsigned char* WT = F.ws + (Q == 0 ? WS_WOUT : WS_WFO);
    const int lane = F.lane, c = lane & 7;
#define LC_LOAD(t_, r_) do { const int kb_ = (r_) / (DM / 32), nb_ = (r_) % (DM / 32); const float* wp_ = W + (size_t)(64 * kb_ + (lane >> 5)) * DM + 32 * nb_ + (lane & 31); \
        _Pragma("unroll") for (int i = 0; i < 32; ++i) t_[i] = wp_[(size_t)(2 * i) * DM]; } while (0)
#define LC_STORE(t_, r_) do { const int kb_ = (r_) / (DM / 32), nb_ = (r_) % (DM / 32); \
        _Pragma("unroll") for (int i = 0; i < 32; ++i) scr[(2 * i + (lane >> 5)) * 33 + (lane & 31)] = t_[i]; \
        LDS_WAIT(); asm volatile("" ::: "memory"); \
        _Pragma("unroll") for (int j = 0; j < 4; ++j) { const int n = (lane >> 3) + 8 * j; const LAS float* s_ = scr + (8 * c) * 33 + n; \
            int lo = __builtin_amdgcn_cvt_pk_fp8_f32(sat8(256.0f * s_[0 * 33]), sat8(256.0f * s_[1 * 33]), 0, false); lo = __builtin_amdgcn_cvt_pk_fp8_f32(sat8(256.0f * s_[2 * 33]), sat8(256.0f * s_[3 * 33]), lo, true); \
            int hi = __builtin_amdgcn_cvt_pk_fp8_f32(sat8(256.0f * s_[4 * 33]), sat8(256.0f * s_[5 * 33]), 0, false); hi = __builtin_amdgcn_cvt_pk_fp8_f32(sat8(256.0f * s_[6 * 33]), sat8(256.0f * s_[7 * 33]), hi, true); \
            u32x2 o8; o8.x = (unsigned)lo; o8.y = (unsigned)hi; *(u32x2*)(WT + (size_t)(32 * nb_ + n) * KD + 64 * kb_ + 8 * c) = o8; } \
        LDS_WAIT(); asm volatile("" ::: "memory"); } while (0)
    int nxt = 0; if (lane == 0) nxt = (int)__hip_atomic_fetch_add(q, (unsigned)CH, __ATOMIC_RELAXED, __HIP_MEMORY_SCOPE_AGENT);
    nxt = __builtin_amdgcn_readfirstlane(nxt);
    while (nxt < NL) {
        const int cur = nxt;
        if (lane == 0) nxt = (int)__hip_atomic_fetch_add(q, (unsigned)CH, __ATOMIC_RELAXED, __HIP_MEMORY_SCOPE_AGENT);
        float ta[32], tb[32];
        LC_LOAD(ta, cur);
#pragma unroll
        for (int e = 0; e < CH; e += 2) {
            LC_LOAD(tb, cur + e + 1);
            LC_STORE(ta, cur + e);
            if (e + 2 < CH) LC_LOAD(ta, cur + e + 2);
            LC_STORE(tb, cur + e + 1);
        }
        nxt = __builtin_amdgcn_readfirstlane(nxt);
    }
#undef LC_LOAD
#undef LC_STORE
}

__device__ __forceinline__ void wq_absmax_item(const float* W, int N, int k0, int n0, unsigned* mx, int lane) {
    const float* wp = W + (size_t)(k0 + (lane >> 5)) * N + n0 + (lane & 31);
    float t[32];
#pragma unroll
    for (int i = 0; i < 32; ++i) t[i] = wp[(size_t)(2 * i) * N];
    float m = 0.f;
#pragma unroll
    for (int i = 0; i < 32; ++i) m = fmaxf(m, fabsf(t[i]));
    m = fmaxf(m, __shfl_xor(m, 32));
    if (lane < 32) atomicMax(mx + lane, __float_as_uint(m));
}
__device__ __forceinline__ void wq_quant_item(const float* W, int K, int N, unsigned char* WT, int drow, LAS float* scr, int k0, int n0, const unsigned* mx, float* SB, int lane) {
    float t[32];
    const float* wp = W + (size_t)(k0 + (lane >> 5)) * N + n0 + (lane & 31);
#pragma unroll
    for (int i = 0; i < 32; ++i) t[i] = wp[(size_t)(2 * i) * N];
#pragma unroll
    for (int i = 0; i < 32; ++i) scr[(2 * i + (lane >> 5)) * 33 + (lane & 31)] = t[i];
    LDS_WAIT(); asm volatile("" ::: "memory");
    const int c = lane & 7;
#pragma unroll
    for (int j = 0; j < 4; ++j) { const int n = (lane >> 3) + 8 * j; const LAS float* sp = scr + (8 * c) * 33 + n;
        const float am = __uint_as_float(mx[n]); const float qs = am > 0.f ? am * (1.0f / 127.0f) : 1.0f, qi = 1.0f / qs;
        if (k0 == 0 && c == 0) SB[drow + n] = qs;
        int q[8];
#pragma unroll
        for (int e = 0; e < 8; ++e) q[e] = __float2int_rn(sp[e * 33] * qi);
        u32x2 o8; o8.x = (unsigned)(q[0] & 255) | ((unsigned)(q[1] & 255) << 8) | ((unsigned)(q[2] & 255) << 16) | ((unsigned)q[3] << 24);
        o8.y = (unsigned)(q[4] & 255) | ((unsigned)(q[5] & 255) << 8) | ((unsigned)(q[6] & 255) << 16) | ((unsigned)q[7] << 24);
        *(u32x2*)(WT + (size_t)(drow + n) * K + k0 + 8 * c) = o8; }
    LDS_WAIT(); asm volatile("" ::: "memory");
}
__device__ __forceinline__ int wfi_drow(int n0) { const int up = n0 >= DFF ? 1 : 0, f = n0 - up * DFF; return (f >> 7) * 256 + up * 128 + (f & 127); }
__device__ __forceinline__ void wq_sweep1(Frame& F) {
    unsigned* ctl = (unsigned*)(F.ws + WS_CTL);
    const int gw = F.bid * NWAVES + F.wave, NGW = F.G * NWAVES;
    constexpr int I_3 = (DM / 64) * (DFF2 / 32);
    for (int it = gw; it < I_3; it += NGW) { const int nblk = DFF2 / 32, kb = it / nblk, nb = it % nblk;
        wq_absmax_item(F.inp(I_WFI), DFF2, 64 * kb, 32 * nb, ctl + CW_WMAX_WFI + wfi_drow(32 * nb), F.lane); }
    constexpr int I_1 = (DM / 64) * 288;
    for (int it = gw; it < I_1; it += NGW) { const int kb = it / 288, nb = it % 288;
        wq_absmax_item(F.inp(I_WIN), DIN, 64 * kb, 32 * nb, ctl + CW_WMAX_WIN + 32 * nb, F.lane); }
}
__device__ __forceinline__ void wq_sweep2(Frame& F) {
    const unsigned* ctl = (const unsigned*)(F.ws + WS_CTL);
    LAS float* scr = (LAS float*)(F.lds + F.wave * 16384);
    const int gw = F.bid * NWAVES + F.wave, NGW = F.G * NWAVES;
    constexpr int I_3 = (DM / 64) * (DFF2 / 32);
    for (int it = gw; it < I_3; it += NGW) { const int nblk = DFF2 / 32, kb = it / nblk, nb = it % nblk; const int drow = wfi_drow(32 * nb);
        wq_quant_item(F.inp(I_WFI), DM, DFF2, F.ws + WS_WFI, drow, scr, 64 * kb, 32 * nb, ctl + CW_WMAX_WFI + drow, (float*)(F.ws + WS_SB_WFI), F.lane); }
}
__device__ __forceinline__ void wq_sweep2_win(Frame& F) {
    const unsigned* ctl = (const unsigned*)(F.ws + WS_CTL);
    LAS float* scr = (LAS float*)(F.lds + F.wave * 16384);
    const int gw = F.bid * NWAVES + F.wave, NGW = F.G * NWAVES;
    constexpr int I_1 = (DM / 64) * 288;
    for (int it = gw; it < I_1; it += NGW) { const int kb = it / 288, nb = it % 288;
        wq_quant_item(F.inp(I_WIN), DM, DIN, F.ws + WS_WIN8, 32 * nb, scr, 64 * kb, 32 * nb, ctl + CW_WMAX_WIN + 32 * nb, (float*)(F.ws + WS_SB_WIN), F.lane); }
}

__device__ __forceinline__ void wq_onepass(Frame& F) {
    LAS unsigned char* T = F.lds;
    constexpr int TPB = 8720, NLG1 = 288, NLG = 288 + 688;
    const int t = F.tid, lane = F.lane;
    const bool affine = (F.G % 16) == 0;
    const int slots = affine ? (F.G >> 1) : 0, slot = affine ? ((F.bid >> 4) * 8 + (F.bid & 7)) : 0, sib = affine ? ((F.bid >> 3) & 1) : 0;
    int cb = affine ? (slot < NLG ? 2 * slot + sib : 2 * NLG) : F.bid; const int cstep = affine ? 2 * slots : F.G;
    f32x4 v[32];
#define WQ_SRC(cb_, Wp_, Np_, c0_) const int lg_ = (cb_) >> 1; const bool w1_ = lg_ < NLG1; const float* Wp_ = w1_ ? F.inp(I_WIN) : F.inp(I_WFI); const int Np_ = w1_ ? DIN : DFF2; const int c0_ = (w1_ ? 32 * lg_ : 32 * (lg_ - NLG1)) + 16 * ((cb_) & 1);
#define WQ_LOAD(cb_) do { WQ_SRC(cb_, Wl_, Nl_, cl_) const float* wl_ = Wl_ + (size_t)(2 * (t >> 2)) * Nl_ + cl_ + 4 * (t & 3); \
        _Pragma("unroll") for (int i = 0; i < 32; ++i) v[i] = *(const f32x4*)(wl_ + (size_t)(256 * (i >> 1) + (i & 1)) * Nl_); } while (0)
    if (cb < 2 * NLG) WQ_LOAD(cb);
    for (; cb < 2 * NLG; cb += cstep) {
        __syncthreads();
#pragma unroll
        for (int j = 0; j < 16; ++j) { const int k = 2 * ((t >> 2) + 128 * j); LAS unsigned char* p = T + (4 * (t & 3)) * TPB + 2 * k + 16 * (k >> 7);
            *(LAS unsigned*)(p) = pkb(v[2 * j].x, v[2 * j + 1].x); *(LAS unsigned*)(p + TPB) = pkb(v[2 * j].y, v[2 * j + 1].y);
            *(LAS unsigned*)(p + 2 * TPB) = pkb(v[2 * j].z, v[2 * j + 1].z); *(LAS unsigned*)(p + 3 * TPB) = pkb(v[2 * j].w, v[2 * j + 1].w); }
        __syncthreads();
        if (cb + cstep < 2 * NLG) WQ_LOAD(cb + cstep);
        WQ_SRC(cb, Wc, Nc, c0)
        (void)Wc; (void)Nc;
        unsigned char* WT = F.ws + (w1_ ? WS_WIN8 : WS_WFI); float* SB = (float*)(F.ws + (w1_ ? WS_SB_WIN : WS_SB_WFI));
#pragma unroll
        for (int cc = 0; cc < 2; ++cc) {
            const int n = 2 * F.wave + cc;
            const int drow = (w1_ ? c0 : wfi_drow(32 * (lg_ - NLG1)) + 16 * (cb & 1)) + n;
            const LAS unsigned char* col = T + n * TPB;
            float m = 0.f;
#pragma unroll
            for (int i = 0; i < 8; ++i) { const int k = 8 * (lane + 64 * i); const u32x4 x = *(const LAS u32x4*)(col + 2 * k + 16 * (k >> 7));
                const unsigned xa[4] = {x.x, x.y, x.z, x.w};
#pragma unroll
                for (int e = 0; e < 4; ++e) m = fmaxf(m, fmaxf(fabsf(__builtin_bit_cast(float, xa[e] << 16)), fabsf(__builtin_bit_cast(float, xa[e] & 0xffff0000u)))); }
#pragma unroll
            for (int off = 32; off >= 1; off >>= 1) m = fmaxf(m, __shfl_xor(m, off));
            const float qs = m > 0.f ? m * (1.0f / 127.0f) : 1.0f, qi = 1.0f / qs;
            if (lane == 0) SB[drow] = qs;
#pragma unroll
            for (int jj = 0; jj < 4; ++jj) { const int c = lane + 64 * jj; const LAS unsigned char* cp = col + 32 * c + 16 * (c >> 3);
                const u32x4 x0 = *(const LAS u32x4*)(cp), x1 = *(const LAS u32x4*)(cp + 16);
                const unsigned xa[8] = {x0.x, x0.y, x0.z, x0.w, x1.x, x1.y, x1.z, x1.w}; unsigned o[4];
#pragma unroll
                for (int e = 0; e < 4; ++e) {
                    const int q0 = __float2int_rn(__builtin_bit_cast(float, xa[2 * e] << 16) * qi), q1 = __float2int_rn(__builtin_bit_cast(float, xa[2 * e] & 0xffff0000u) * qi);
                    const int q2 = __float2int_rn(__builtin_bit_cast(float, xa[2 * e + 1] << 16) * qi), q3 = __float2int_rn(__builtin_bit_cast(float, xa[2 * e + 1] & 0xffff0000u) * qi);
                    o[e] = (unsigned)(q0 & 255) | ((unsigned)(q1 & 255) << 8) | ((unsigned)(q2 & 255) << 16) | ((unsigned)q3 << 24); }
                u32x4 ov; ov.x = o[0]; ov.y = o[1]; ov.z = o[2]; ov.w = o[3];
                *(u32x4*)(WT + (size_t)drow * DM + 16 * c) = ov; }
        }
    }
#undef WQ_LOAD
#undef WQ_SRC
}

__device__ __forceinline__ void p2b_thin(Frame& F) {
    const u16* H = (const u16*)(F.ws + WS_H); const u16* W = (const u16*)(F.ws + WS_WIN) + (size_t)WIN_KI_ROW * DM;
    u16* KI = (u16*)(F.ws + WS_KI); float* WI = (float*)(F.ws + WS_WI);
    const int kq = F.wave & 3, rh = F.wave >> 2, fr = F.lane & 15, fq = F.lane >> 4;
    LAS float* part = (LAS float*)F.lds;
    for (int u = F.bid; u < M / 64; u += F.G) {
        const u16* ap = H + (size_t)(64 * u + 32 * rh + fr) * DM + 1024 * kq + 8 * fq;
        const u16* bp = W + (size_t)fr * DM + 1024 * kq + 8 * fq;
        f32x4 acc[2][6];
#pragma unroll
        for (int m = 0; m < 2; ++m)
#pragma unroll
            for (int n = 0; n < 6; ++n) acc[m][n] = (f32x4){0.f, 0.f, 0.f, 0.f};
        f16x8 a0[2][2], b0[6][2], a1[2][2], b1[6][2];
#define P2B_LOAD(a, b, s) do { _Pragma("unroll") for (int m = 0; m < 2; ++m) _Pragma("unroll") for (int h = 0; h < 2; ++h) a[m][h] = *(const f16x8*)(ap + (size_t)(16 * m) * DM + 64 * (s) + 32 * h); \
        _Pragma("unroll") for (int n = 0; n < 6; ++n) _Pragma("unroll") for (int h = 0; h < 2; ++h) b[n][h] = *(const f16x8*)(bp + (size_t)(16 * n) * DM + 64 * (s) + 32 * h); } while (0)
#define P2B_MMA(a, b) do { _Pragma("unroll") for (int m = 0; m < 2; ++m) _Pragma("unroll") for (int n = 0; n < 6; ++n) _Pragma("unroll") for (int h = 0; h < 2; ++h) \
        acc[m][n] = __builtin_amdgcn_mfma_f32_16x16x32_f16(b[n][h], a[m][h], acc[m][n], 0, 0, 0); } while (0)
        P2B_LOAD(a0, b0, 0);
#pragma unroll 1
        for (int s = 0; s < 16; s += 2) {
            P2B_LOAD(a1, b1, s + 1);
            P2B_MMA(a0, b0);
            if (s + 2 < 16) P2B_LOAD(a0, b0, s + 2);
            P2B_MMA(a1, b1);
        }
#undef P2B_LOAD
#undef P2B_MMA
#pragma unroll
        for (int m = 0; m < 2; ++m)
#pragma unroll
            for (int n = 0; n < 6; ++n) *(LAS f32x4*)(part + (kq * 64 + 32 * rh + 16 * m + fr) * 100 + 16 * n + 4 * fq) = acc[m][n];
        __syncthreads();
        { const int r = 8 * F.wave + (F.lane >> 3), c8 = F.lane & 7;
          f32x4 s0 = {0.f, 0.f, 0.f, 0.f}, s1 = s0, s2 = s0;
#pragma unroll
          for (int q = 0; q < 4; ++q) { const LAS float* p = part + (q * 64 + r) * 100; s0 += *(const LAS f32x4*)(p + 8 * c8); s1 += *(const LAS f32x4*)(p + 8 * c8 + 4); s2 += *(const LAS f32x4*)(p + 64 + 4 * c8); }
          u32x4 w; w.x = pkh(s0[0], s0[1]); w.y = pkh(s0[2], s0[3]); w.z = pkh(s1[0], s1[1]); w.w = pkh(s1[2], s1[3]);
          *(u32x4*)(KI + (size_t)(64 * u + r) * IDIM + 8 * c8) = w;
          *(f32x4*)(WI + (size_t)(64 * u + r) * NIH + 4 * c8) = s2; }
        __syncthreads();
    }
}

__device__ __forceinline__ void p3_phase(Frame& F) {
    LAS float* xc = (LAS float*)F.lds; LAS float* as = xc + 64 * 128; LAS float* us = as + 64 * 128;
    const u16* XL = (const u16*)(F.ws + WS_XL); const u16* GT = (const u16*)(F.ws + WS_GATE); float* YL = (float*)(F.ws + WS_YL);
    const float* cw = F.inp(I_CLW); const float* cbias = F.inp(I_CLB);
    for (int unit = F.bid; unit < BATCH * NLB; unit += F.G) {
        const int b = unit / NLB, nb = unit % NLB;
        const int jj = F.tid & 127, tg = F.tid >> 7, dj = nb * LB + jj;
        const float lam = F.inp(I_LAM)[dj];
        const float cdec = -8.0f * log1pf(expf(-lam));
        const float ba = F.inp(I_BRA)[dj], bx = F.inp(I_BRX)[dj];
        const float* wa = F.inp(I_WRA) + (size_t)nb * LB * LB + jj; const float* wx = F.inp(I_WRX) + (size_t)nb * LB * LB + jj;
        float hstate = 0.f;
        for (int tile = 0; tile < SEQ / 64; ++tile) {
            const int t0 = tile * 64;
            for (int e = F.tid; e < 64 * 128; e += NTHR) { const int tt = e >> 7, ch = e & 127, t = t0 + tt, d = nb * LB + ch; float v = cbias[d];
#pragma unroll
                for (int j = 0; j < 4; ++j) { const int ts = t - 3 + j; if (ts >= 0) v += cw[j * DLRU + d] * h2f(XL[(size_t)(b * SEQ + ts) * DLRU + d]); }
                xc[e] = v; }
            __syncthreads();
            float accr[16], acci[16];
#pragma unroll
            for (int tt = 0; tt < 16; ++tt) { accr[tt] = 0.f; acci[tt] = 0.f; }
            for (int i4 = 0; i4 < 32; ++i4) {
                float wav[4], wxv[4];
#pragma unroll
                for (int e = 0; e < 4; ++e) { wav[e] = wa[(size_t)(4 * i4 + e) * LB]; wxv[e] = wx[(size_t)(4 * i4 + e) * LB]; }
#pragma unroll
                for (int tt = 0; tt < 16; ++tt) { const f32x4 xv = *(const LAS f32x4*)(xc + (tg * 16 + tt) * 128 + 4 * i4);
                    accr[tt] += xv.x * wav[0] + xv.y * wav[1] + xv.z * wav[2] + xv.w * wav[3];
                    acci[tt] += xv.x * wxv[0] + xv.y * wxv[1] + xv.z * wxv[2] + xv.w * wxv[3]; }
            }
#pragma unroll
            for (int tt = 0; tt < 16; ++tt) { const int tl = tg * 16 + tt;
                const float r = sigmoidf_(accr[tt] + ba), ig = sigmoidf_(acci[tt] + bx);
                const float la = cdec * r; const float a = expf(la); const float mult = sqrtf(-expm1f(2.0f * la));
                as[tl * 128 + jj] = a; us[tl * 128 + jj] = mult * ig * xc[tl * 128 + jj]; }
            __syncthreads();
            if (F.tid < 128) {
                for (int tt = 0; tt < 64; ++tt) { hstate = as[tt * 128 + F.tid] * hstate + us[tt * 128 + F.tid];
                    const size_t o = (size_t)(b * SEQ + t0 + tt) * DLRU + dj;
                    YL[o] = hstate * gelu_tanh(h2f(GT[o])); }
            }
            __syncthreads();
        }
    }
}

struct Frame;
__device__ __forceinline__ void chk_flag(Frame& F, int bit, bool bad);
__device__ __forceinline__ float shfl_up16(float v) { return __shfl_up(v, 16); }
__device__ __forceinline__ void p3_fast(Frame& F) {
    LAS unsigned char* xc16 = F.lds;
    LAS float* xc32 = (LAS float*)(F.lds + 17408);
    LAS u16* gt16 = (LAS u16*)(F.lds + 17408 + 32768);
    const u16* XL = (const u16*)(F.ws + WS_XL); const u16* GT = (const u16*)(F.ws + WS_GATE); float* YL = (float*)(F.ws + WS_YL);
    const u16* WT = (const u16*)(F.ws + WS_WRG);
    const int lane = F.lane, cl = lane & 15, lg = lane >> 4;
    const int chunk8 = F.tid & 15, trow = F.tid >> 4;
    for (int unit = F.bid; unit < BATCH * NLB; unit += F.G) {
        const int b = unit / NLB, nb = unit % NLB;
        const int c = 16 * F.wave + cl, d = nb * LB + c;
        const float lam = F.inp(I_LAM)[d], cdec = -8.0f * log1pf(expf(-lam)), ba = F.inp(I_BRA)[d], bx = F.inp(I_BRX)[d];
        f16x8 Bfr[2][4];
#pragma unroll
        for (int wh = 0; wh < 2; ++wh)
#pragma unroll
            for (int ks = 0; ks < 4; ++ks) Bfr[wh][ks] = *(const f16x8*)(WT + ((size_t)(nb * 256 + wh * 128 + c) * LB + ks * 32 + 8 * lg));
        const int dc = nb * LB + 8 * chunk8;
        f32x4 cw0[4], cw1[4]; const f32x4 cb0 = *(const f32x4*)(F.inp(I_CLB) + dc), cb1 = *(const f32x4*)(F.inp(I_CLB) + dc + 4);
#pragma unroll
        for (int j = 0; j < 4; ++j) { cw0[j] = *(const f32x4*)(F.inp(I_CLW) + j * DLRU + dc); cw1[j] = *(const f32x4*)(F.inp(I_CLW) + j * DLRU + dc + 4); }
        float carry = 0.f;
        u32x4 xr[2][4], gr[2];
        const u32x4 z4 = {0u, 0u, 0u, 0u};
#define P3_LOAD(tile_) do { _Pragma("unroll") for (int ps = 0; ps < 2; ++ps) { const int t_ = (tile_) * 64 + trow + 32 * ps; \
            _Pragma("unroll") for (int j = 0; j < 4; ++j) { const int ts_ = t_ - 3 + j; xr[ps][j] = z4; if (ts_ >= 0) xr[ps][j] = *(const u32x4*)(XL + (size_t)(b * SEQ + ts_) * DLRU + dc); } \
            gr[ps] = *(const u32x4*)(GT + (size_t)(b * SEQ + t_) * DLRU + dc); } } while (0)
        P3_LOAD(0);
        for (int tile = 0; tile < SEQ / 64; ++tile) {
            const int t0 = tile * 64;
#pragma unroll
            for (int ps = 0; ps < 2; ++ps) {
                const int row = trow + 32 * ps;
                f32x4 v0 = cb0, v1 = cb1;
#pragma unroll
                for (int j = 0; j < 4; ++j) { const u32x4 w = xr[ps][j];
                    const f32x4 x0 = {h2f((u16)(w.x & 0xffffu)), h2f((u16)(w.x >> 16)), h2f((u16)(w.y & 0xffffu)), h2f((u16)(w.y >> 16))};
                    const f32x4 x1 = {h2f((u16)(w.z & 0xffffu)), h2f((u16)(w.z >> 16)), h2f((u16)(w.w & 0xffffu)), h2f((u16)(w.w >> 16))};
                    v0 += cw0[j] * x0; v1 += cw1[j] * x1; }
                *(LAS f32x4*)(xc32 + row * 128 + 8 * chunk8) = v0; *(LAS f32x4*)(xc32 + row * 128 + 8 * chunk8 + 4) = v1;
                u32x4 pk; pk.x = pkh(v0.x, v0.y); pk.y = pkh(v0.z, v0.w); pk.z = pkh(v1.x, v1.y); pk.w = pkh(v1.z, v1.w);
                *(LAS u32x4*)(xc16 + row * 272 + chunk8 * 16) = pk;
                *(LAS u32x4*)(gt16 + row * 128 + 8 * chunk8) = gr[ps];
            }
            __syncthreads();
            if (tile + 1 < SEQ / 64) P3_LOAD(tile + 1);
            f32x4 Cr[4], Ci[4];
#pragma unroll
            for (int mt = 0; mt < 4; ++mt) { f32x4 cr = {0.f, 0.f, 0.f, 0.f}, ci = cr;
#pragma unroll
                for (int ks = 0; ks < 4; ++ks) { const f16x8 a = *(const LAS f16x8*)(xc16 + (16 * mt + cl) * 272 + ks * 64 + lg * 16);
                    cr = __builtin_amdgcn_mfma_f32_16x16x32_f16(a, Bfr[0][ks], cr, 0, 0, 0); ci = __builtin_amdgcn_mfma_f32_16x16x32_f16(a, Bfr[1][ks], ci, 0, 0, 0); }
                Cr[mt] = cr; Ci[mt] = ci; }
#pragma unroll
            for (int mt = 0; mt < 4; ++mt) {
                float av[4], hv[4]; float P = 1.f, S = 0.f;
                {
                    const int tk = 16 * mt + 4 * lg;
                    const f32x4 xv = {xc32[tk * 128 + c], xc32[(tk + 1) * 128 + c], xc32[(tk + 2) * 128 + c], xc32[(tk + 3) * 128 + c]};
                    const f32x4 zr = (Cr[mt] + ba) * -1.4426950408889634f, zi = (Ci[mt] + bx) * -1.4426950408889634f;
                    const f32x4 dr = (f32x4){__builtin_amdgcn_exp2f(zr.x), __builtin_amdgcn_exp2f(zr.y), __builtin_amdgcn_exp2f(zr.z), __builtin_amdgcn_exp2f(zr.w)} + 1.0f;
                    const f32x4 di = (f32x4){__builtin_amdgcn_exp2f(zi.x), __builtin_amdgcn_exp2f(zi.y), __builtin_amdgcn_exp2f(zi.z), __builtin_amdgcn_exp2f(zi.w)} + 1.0f;
                    const f32x4 r = {__builtin_amdgcn_rcpf(dr.x), __builtin_amdgcn_rcpf(dr.y), __builtin_amdgcn_rcpf(dr.z), __builtin_amdgcn_rcpf(dr.w)};
                    const f32x4 ig = {__builtin_amdgcn_rcpf(di.x), __builtin_amdgcn_rcpf(di.y), __builtin_amdgcn_rcpf(di.z), __builtin_amdgcn_rcpf(di.w)};
                    const f32x4 l2 = r * (cdec * 1.4426950408889634f), x2 = r * (2.0f * cdec);
                    const f32x4 a4 = {__builtin_amdgcn_exp2f(l2.x), __builtin_amdgcn_exp2f(l2.y), __builtin_amdgcn_exp2f(l2.z), __builtin_amdgcn_exp2f(l2.w)};
                    const f32x4 om = -x2 * (1.0f + 0.5f * x2 * (1.0f + (1.0f / 3.0f) * x2 * (1.0f + 0.25f * x2 * (1.0f + 0.2f * x2 * (1.0f + (1.0f / 6.0f) * x2)))));
                    const f32x4 u4 = (f32x4){__builtin_amdgcn_sqrtf(om.x), __builtin_amdgcn_sqrtf(om.y), __builtin_amdgcn_sqrtf(om.z), __builtin_amdgcn_sqrtf(om.w)} * (ig * xv);
                    const float ua[4] = {u4.x, u4.y, u4.z, u4.w}, aa[4] = {a4.x, a4.y, a4.z, a4.w};
#pragma unroll
                    for (int e = 0; e < 4; ++e) { S = aa[e] * S + ua[e]; P = P * aa[e]; av[e] = P; hv[e] = S; }
                }
                float Pin = 1.f, Sin = 0.f;
                { float Pq = P, Sq = S;
                  float Pu = shfl_up16(Pq), Su = shfl_up16(Sq); if (lg >= 1) { Sq = Pq * Su + Sq; Pq = Pq * Pu; }
                  Pu = __shfl_up(Pq, 32); Su = __shfl_up(Sq, 32); if (lg >= 2) { Sq = Pq * Su + Sq; Pq = Pq * Pu; }
                  Pu = shfl_up16(Pq); Su = shfl_up16(Sq); if (lg >= 1) { Pin = Pu; Sin = Su; }
                  const float hin = Sin + Pin * carry;
#pragma unroll
                  for (int e = 0; e < 4; ++e) hv[e] = hv[e] + av[e] * hin;
                  carry = __shfl(hv[3], 48 + cl);
                }
                { const int tk = 16 * mt + 4 * lg;
                  const f32x4 gg = gelu_tanh4((f32x4){h2f(gt16[tk * 128 + c]), h2f(gt16[(tk + 1) * 128 + c]), h2f(gt16[(tk + 2) * 128 + c]), h2f(gt16[(tk + 3) * 128 + c])});
                  const float ga4[4] = {gg.x, gg.y, gg.z, gg.w};
#pragma unroll
                  for (int e = 0; e < 4; ++e) { const size_t o = (size_t)(b * SEQ + t0 + tk + e) * DLRU + d; YL[o] = hv[e] * ga4[e]; } }
            }
            __syncthreads();
        }
#undef P3_LOAD
    }
}

__device__ __forceinline__ unsigned f2key(float f) { const unsigned u = __builtin_bit_cast(unsigned, f); return (u & 0x80000000u) ? ~u : (u | 0x80000000u); }
__device__ __forceinline__ int block_sum_i(Frame& F, LAS int* slots, int v) {
    const int w = (int)wave_sum((float)v);
    if (F.lane == 0) slots[F.wave] = w;
    __syncthreads();
    int s = 0;
#pragma unroll
    for (int i = 0; i < 8; ++i) s += slots[i];
    __syncthreads();
    return s;
}
__device__ __forceinline__ void p4_phase(Frame& F) {
    LAS float* qs = (LAS float*)F.lds;
    LAS float* wts = qs + 2048;
    LAS int* slots = (LAS int*)(wts + 32);
    LAS int* cnts = slots + 8;
    LAS int* sel = cnts + 64;
    LAS float* qa = (LAS float*)(sel + 256);
    LAS float* lg = qa + 2048;
    LAS float* red = lg + 4096;
    const u16* QI = (const u16*)(F.ws + WS_QI); const u16* KI = (const u16*)(F.ws + WS_KI); const float* WI = (const float*)(F.ws + WS_WI);
    const u16* Q = (const u16*)(F.ws + WS_Q); const u16* K = (const u16*)(F.ws + WS_K); const u16* V = (const u16*)(F.ws + WS_V);
    u16* MG = (u16*)(F.ws + WS_MERGED);
#if MK_DIAG
    for (int gq = F.bid * 64 + (F.bid * 7) % 64, once = 0; once < 1; ++once) {
#else
    for (int gq = F.bid; gq < M; gq += F.G) {
#endif
        const int b = gq / SEQ, t = gq % SEQ, nvalid = t + 1;
        for (int i = F.tid; i < NIH * IDIM; i += NTHR) qs[i] = h2f(QI[(size_t)gq * (NIH * IDIM) + i]);
        if (F.tid < NIH) wts[F.tid] = WI[(size_t)gq * NIH + F.tid];
        for (int i = F.tid; i < NH * HD; i += NTHR) qa[i] = h2f(Q[(size_t)gq * DATT + i]) * ATT_SCALE;
        __syncthreads();
        unsigned uk[8];
#pragma unroll
        for (int j = 0; j < 8; ++j) {
            const int key = F.tid + 512 * j;
            uk[j] = 0u;
            if (F.wave * 64 + 512 * j <= t) {
                const int kk = key <= t ? key : t;
                const u32x4* kp = (const u32x4*)(KI + (size_t)(b * SEQ + kk) * IDIM);
                float kf[64];
#pragma unroll
                for (int c8 = 0; c8 < 8; ++c8) { const u32x4 w = kp[c8];
                    const unsigned ww[4] = {w.x, w.y, w.z, w.w};
#pragma unroll
                    for (int e = 0; e < 4; ++e) { kf[c8 * 8 + 2 * e] = h2f((u16)(ww[e] & 0xffffu)); kf[c8 * 8 + 2 * e + 1] = h2f((u16)(ww[e] >> 16)); } }
                float score = 0.f;
#pragma unroll 1
                for (int h = 0; h < NIH; ++h) {
                    float d0 = 0.f, d1 = 0.f;
#pragma unroll
                    for (int c4 = 0; c4 < 16; ++c4) { const f32x4 qv = *(const LAS f32x4*)(qs + h * 64 + 4 * c4);
                        d0 += kf[4 * c4] * qv.x + kf[4 * c4 + 1] * qv.y; d1 += kf[4 * c4 + 2] * qv.z + kf[4 * c4 + 3] * qv.w; }
                    score += fmaxf(d0 + d1, 0.f) * wts[h];
                }
                if (key <= t) uk[j] = f2key(score);
            }
        }
#if MK_DIAG
        { bool bad = false;
#pragma unroll
          for (int j = 0; j < 8; ++j) { const unsigned a = uk[j], bq = ((const unsigned*)(F.ws + WS_ACT + 32 * MiB))[(size_t)(gq >> 6) * 4096 + F.tid + 512 * j];
              const float fa = __builtin_bit_cast(float, (a & 0x80000000u) ? (a ^ 0x80000000u) : ~a), fb = __builtin_bit_cast(float, (bq & 0x80000000u) ? (bq ^ 0x80000000u) : ~bq);
              float df = (a == 0u || bq == 0u) ? ((a != bq) ? 1000.0f : 0.f) : fabsf(fa - fb);
              const bool ok = !(a == 0u || bq == 0u); const float sab = wave_sum(ok ? fa * fb : 0.f), sbb = wave_sum(ok ? fb * fb : 0.f); (void)df;
              if (F.lane == 0) { atomicAdd((float*)(F.ws + WS_CTL) + CW_FLAGS + 1, sab); atomicAdd((float*)(F.ws + WS_CTL) + CW_FLAGS + 2, sbb); } }
          bad = false;
          if (__any(bad)) chk_flag(F, 2, true); }
#endif
        int nsel;
        if (nvalid <= TOPK) {
            nsel = nvalid;
            if (F.tid < nvalid) sel[F.tid] = F.tid;
            __syncthreads();
        } else {
            unsigned T = 0u; int cge = 0;
            for (int bit = 31; bit >= 0; --bit) {
                const unsigned cand = T | (1u << bit);
                int c = 0;
#pragma unroll
                for (int j = 0; j < 8; ++j) c += (uk[j] >= cand) ? 1 : 0;
                c = block_sum_i(F, slots, c);
                if (c >= TOPK) { T = cand; cge = c; if (c == TOPK) break; }
            }
            int cgt = 0;
            if (cge > TOPK) { int c = 0;
#pragma unroll
                for (int j = 0; j < 8; ++j) c += (uk[j] > T) ? 1 : 0;
                cgt = block_sum_i(F, slots, c); }
            const unsigned long long lmask = (1ull << F.lane) - 1ull;
            int myoff[8];
#pragma unroll
            for (int j = 0; j < 8; ++j) { const bool f = (cge == TOPK) ? (uk[j] >= T) : (uk[j] > T); const unsigned long long bl = __ballot(f);
                myoff[j] = __popcll(bl & lmask); if (F.lane == 0) cnts[j * 8 + F.wave] = __popcll(bl); }
            __syncthreads();
            { int run = 0;
#pragma unroll
              for (int j = 0; j < 8; ++j) {
#pragma unroll
                for (int w = 0; w < 8; ++w) { const int cv = cnts[j * 8 + w]; if (w == F.wave) myoff[j] += run; run += cv; } } }
#pragma unroll
            for (int j = 0; j < 8; ++j) { const bool f = (cge == TOPK) ? (uk[j] >= T) : (uk[j] > T); if (f && myoff[j] < TOPK) sel[myoff[j]] = F.tid + 512 * j; }
            __syncthreads();
            if (cge > TOPK) {
#pragma unroll
                for (int j = 0; j < 8; ++j) { const bool f = (uk[j] == T); const unsigned long long bl = __ballot(f);
                    myoff[j] = __popcll(bl & lmask); if (F.lane == 0) cnts[j * 8 + F.wave] = __popcll(bl); }
                __syncthreads();
                { int run = 0;
#pragma unroll
                  for (int j = 0; j < 8; ++j) {
#pragma unroll
                    for (int w = 0; w < 8; ++w) { const int cv = cnts[j * 8 + w]; if (w == F.wave) myoff[j] += run; run += cv; } } }
#pragma unroll
                for (int j = 0; j < 8; ++j) { const bool f = (uk[j] == T); if (f && cgt + myoff[j] < TOPK) sel[cgt + myoff[j]] = F.tid + 512 * j; }
                __syncthreads();
            }
            nsel = TOPK;
        }
#if MK_DIAG
        int selsame;
        { const unsigned mine = F.tid < 256 ? (F.tid < nsel ? (unsigned)sel[F.tid] : 0xffffffffu) : 0u, theirs = F.tid < 256 ? ((const unsigned*)(F.ws + WS_ACT))[(size_t)gq * 256 + F.tid] : 0u;
          const int nd = block_sum_i(F, slots, mine != theirs ? 1 : 0);
          selsame = (nd == 0);
          if (nd > 24) chk_flag(F, 0, true); }
#endif
        {
            const int j = F.tid & 255, gp = F.tid >> 8;
            if (j < nsel) {
                const int key = sel[j];
#pragma unroll 1
                for (int gi = 0; gi < 2; ++gi) {
                    const int g = 2 * gp + gi;
                    const u32x4* kp = (const u32x4*)(K + (size_t)(b * SEQ + key) * DKV + g * HD);
                    float d[4] = {0.f, 0.f, 0.f, 0.f};
#pragma unroll 4
                    for (int c8 = 0; c8 < 16; ++c8) { const u32x4 w = kp[c8]; const unsigned ww[4] = {w.x, w.y, w.z, w.w}; float kf[8];
#pragma unroll
                        for (int e = 0; e < 4; ++e) { kf[2 * e] = h2f((u16)(ww[e] & 0xffffu)); kf[2 * e + 1] = h2f((u16)(ww[e] >> 16)); }
#pragma unroll
                        for (int hh = 0; hh < 4; ++hh) { const LAS float* qp = qa + (4 * g + hh) * HD + c8 * 8; const f32x4 q0 = *(const LAS f32x4*)qp, q1 = *(const LAS f32x4*)(qp + 4);
                            d[hh] += kf[0] * q0.x + kf[1] * q0.y + kf[2] * q0.z + kf[3] * q0.w + kf[4] * q1.x + kf[5] * q1.y + kf[6] * q1.z + kf[7] * q1.w; } }
#pragma unroll
                    for (int hh = 0; hh < 4; ++hh) lg[(4 * g + hh) * 256 + j] = d[hh];
                }
            }
        }
        __syncthreads();
#pragma unroll 1
        for (int hi = 0; hi < 2; ++hi) { const int h = 2 * F.wave + hi; float v[4]; float mx = -3.0e38f;
#pragma unroll
            for (int i = 0; i < 4; ++i) { const int j = F.lane + 64 * i; v[i] = (j < nsel) ? lg[h * 256 + j] : -3.0e38f; mx = fmaxf(mx, v[i]); }
            mx = wave_max(mx); float s = 0.f;
#pragma unroll
            for (int i = 0; i < 4; ++i) { const int j = F.lane + 64 * i; v[i] = (j < nsel) ? fast_exp(v[i] - mx) : 0.f; s += v[i]; }
            s = wave_sum(s); const float inv = 1.0f / s;
#pragma unroll
            for (int i = 0; i < 4; ++i) lg[h * 256 + F.lane + 64 * i] = v[i] * inv; }
        __syncthreads();
#if MK_DIAG
        if (selsame) { bool bad = false;
            for (int k = F.tid; k < 2048; k += NTHR) { const int jp = k >> 4, h = k & 15; const unsigned w = ((const unsigned*)(F.ws + WS_ACT + 40 * MiB))[(size_t)(gq >> 6) * 2048 + k];
                const float p0 = h2f((u16)(w & 0xffffu)), p1 = h2f((u16)(w >> 16));
                const float r0 = (2 * jp < nsel) ? lg[h * 256 + 2 * jp] : 0.f, r1 = (2 * jp + 1 < nsel) ? lg[h * 256 + 2 * jp + 1] : 0.f;
                bad |= !(fabsf(p0 - r0) <= 0.01f * r0 + 2e-4f) || !(fabsf(p1 - r1) <= 0.01f * r1 + 2e-4f); }
            if (__any(bad)) chk_flag(F, 3, true); }
#endif
        {
            const int g = F.tid >> 7, d = F.tid & 127;
            float o[4] = {0.f, 0.f, 0.f, 0.f};
            const u16* vb = V + (size_t)b * SEQ * DKV + g * HD + d;
#pragma unroll 8
            for (int j = 0; j < nsel; ++j) { const float vv = h2f(vb[(size_t)sel[j] * DKV]);
#pragma unroll
                for (int hh = 0; hh < 4; ++hh) o[hh] += lg[(4 * g + hh) * 256 + j] * vv; }
            float ss = (o[0] * o[0] + o[1] * o[1]) + (o[2] * o[2] + o[3] * o[3]);
            ss = wave_sum(ss);
            if (F.lane == 0) red[F.wave] = ss;
            __syncthreads();
            float tot = 0.f;
#pragma unroll
            for (int i = 0; i < 8; ++i) tot += red[i];
            const float rstd = 1.0f / sqrtf(tot * (1.0f / DATT) + RMS_EPS);
            const float* ga = F.inp(I_GATTN);
#if MK_DIAG
            { bool bad = false;
#pragma unroll
              for (int hh = 0; hh < 4; ++hh) { const int idx = (4 * g + hh) * HD + d; const float ref = o[hh] * rstd * ga[idx], got = h2f(MG[(size_t)gq * DM + DLRU + idx]); bad |= !(fabsf(got - ref) <= 0.02f * fabsf(ref) + 0.02f); }
              if (selsame && __any(bad)) chk_flag(F, 1, true); }
#else
#pragma unroll
            for (int hh = 0; hh < 4; ++hh) { const int idx = (4 * g + hh) * HD + d; MG[(size_t)gq * DM + DLRU + idx] = __builtin_bit_cast(u16, (f16)(o[hh] * rstd * ga[idx])); }
#endif
        }
        __syncthreads();
    }
}

typedef float f32x16 __attribute__((ext_vector_type(16)));
__device__ __forceinline__ void p4_fast(Frame& F) {
    LAS unsigned char* kring = F.lds;
    LAS unsigned* selw = (LAS unsigned*)(F.lds + 65536 + F.wave * 1024);
    const int lane = F.lane, r32 = lane & 31, hi = lane >> 5, head = lane & 15, kq = lane >> 4;
    const u16* QI = (const u16*)(F.ws + WS_QI); const u16* KI = (const u16*)(F.ws + WS_KI); const float* WI = (const float*)(F.ws + WS_WI);
    const u16* Q = (const u16*)(F.ws + WS_Q); const u16* K = (const u16*)(F.ws + WS_K); const u16* V = (const u16*)(F.ws + WS_V);
    u16* MG = (u16*)(F.ws + WS_MERGED);
    const int srow = F.tid >> 3, scol = ((F.tid & 7) ^ ((srow >> 1) & 7)) * 8;
    int rdoff[4];
#pragma unroll
    for (int ks = 0; ks < 4; ++ks) rdoff[ks] = r32 * 128 + (((2 * ks + hi) ^ ((r32 >> 1) & 7)) * 16);
    const unsigned long long lmask = (1ull << lane) - 1ull;
    LAS int* qslot = (LAS int*)(F.lds + 73728 + 8 * 8704);
    int ntk = 0;
    if (F.tid == 0) ntk = (int)__hip_atomic_fetch_add((unsigned*)(F.ws + WS_CTL) + CW_QUEUE, 1u, __ATOMIC_RELAXED, __HIP_MEMORY_SCOPE_AGENT);
    for (;;) {
        asm volatile("s_waitcnt lgkmcnt(0)" ::: "memory"); __builtin_amdgcn_s_barrier(); asm volatile("" ::: "memory");
        if (F.tid == 0) *qslot = ntk;
        asm volatile("s_waitcnt lgkmcnt(0)" ::: "memory"); __builtin_amdgcn_s_barrier(); asm volatile("" ::: "memory");
        const int it = *qslot; if (it >= M / 8) break;
        const int b = it >> 9, gi = 511 - (it & 511);
        const int t0 = gi * 8, t = t0 + F.wave, gq = b * SEQ + t, NT = (t0 >> 6) + 1, nvalid = t + 1;
        const u16* kb = KI + (size_t)b * SEQ * IDIM;
#define P4_STAGE(i) __builtin_amdgcn_global_load_lds((const unsigned*)(kb + (size_t)(64 * (i) + srow) * IDIM + scol), (LAS unsigned*)(kring + ((i) & 7) * 8192 + F.wave * 1024), 16, 0, 0)
#if !P4_DIRECT
        P4_STAGE(0); if (1 < NT) P4_STAGE(1); if (2 < NT) P4_STAGE(2); if (3 < NT) P4_STAGE(3); if (4 < NT) P4_STAGE(4); if (5 < NT) P4_STAGE(5);
#endif
        f16x8 qa[4]; float wreg[16];
#pragma unroll
        for (int ks = 0; ks < 4; ++ks) qa[ks] = *(const f16x8*)(QI + (size_t)gq * (NIH * IDIM) + r32 * IDIM + ks * 16 + hi * 8);
#pragma unroll
        for (int r = 0; r < 16; ++r) wreg[r] = WI[(size_t)gq * NIH + (r & 3) + 8 * (r >> 2) + 4 * hi];
        unsigned uk[64];
#define P4_SCORE(i_) do { const LAS unsigned char* slot = kring + ((i_) & 7) * 8192; float sA = 0.f, sB = 0.f; \
                {                                                     \
                    f16x8 bfa[4], bfb[4]; \
                    _Pragma("unroll") for (int ks = 0; ks < 4; ++ks) { bfa[ks] = *(const LAS f16x8*)(slot + rdoff[ks]); bfb[ks] = *(const LAS f16x8*)(slot + 4096 + rdoff[ks]); } \
                    f32x16 accA = {}, accB = {}; f32x2 pA = {0.f, 0.f}, pB = {0.f, 0.f}; \
                    _Pragma("unroll") for (int ks = 0; ks < 4; ++ks) { accA = __builtin_amdgcn_mfma_f32_32x32x16_f16(qa[ks], bfa[ks], accA, 0, 0, 0); accB = __builtin_amdgcn_mfma_f32_32x32x16_f16(qa[ks], bfb[ks], accB, 0, 0, 0); } \
                    _Pragma("unroll") for (int r = 0; r < 16; r += 2) { const f32x2 w2 = {wreg[r], wreg[r + 1]};                         \
                        const f32x2 ra = {__builtin_amdgcn_fmed3f(accA[r], 0.f, 3.0e38f), __builtin_amdgcn_fmed3f(accA[r + 1], 0.f, 3.0e38f)}, rb = {__builtin_amdgcn_fmed3f(accB[r], 0.f, 3.0e38f), __builtin_amdgcn_fmed3f(accB[r + 1], 0.f, 3.0e38f)}; \
                        pA += ra * w2; pB += rb * w2; } \
                    sA = pA.x + pA.y; sB = pB.x + pB.y; \
                } \
                const auto sw = __builtin_amdgcn_permlane32_swap(__builtin_bit_cast(unsigned, sA), __builtin_bit_cast(unsigned, sB), false, false); \
                const unsigned sw0 = sw[0], sw1 = sw[1];                   \
                const float score = __uint_as_float(sw0) + __uint_as_float(sw1);     \
                uk[i_] = (64 * (i_) + lane <= t) ? f2key(score) : 0u; } while (0)
#pragma unroll
        for (int ip = 0; ip < 32; ++ip) {
            uk[2 * ip] = 0u; uk[2 * ip + 1] = 0u;
            if (2 * ip < NT) {
                { const int last = (2 * ip + 1 < NT) ? 2 * ip + 1 : 2 * ip, yg = NT - 1 - last;
                  if (yg >= 4) asm volatile("s_waitcnt vmcnt(4) lgkmcnt(0)" ::: "memory"); else if (yg == 3) asm volatile("s_waitcnt vmcnt(3) lgkmcnt(0)" ::: "memory");
                  else if (yg == 2) asm volatile("s_waitcnt vmcnt(2) lgkmcnt(0)" ::: "memory"); else if (yg == 1) asm volatile("s_waitcnt vmcnt(1) lgkmcnt(0)" ::: "memory");
                  else asm volatile("s_waitcnt vmcnt(0) lgkmcnt(0)" ::: "memory"); }
                __builtin_amdgcn_s_barrier(); asm volatile("" ::: "memory");
                if (2 * ip + 6 < NT) P4_STAGE(2 * ip + 6);
                if (2 * ip + 7 < NT) P4_STAGE(2 * ip + 7);
                P4_SCORE(2 * ip);
                if (2 * ip + 1 < NT) P4_SCORE(2 * ip + 1);
            }
        }
#undef P4_SCORE
#if MK_DIAG
        if ((((gq >> 6) * 7) & 63) == (gq & 63)) {
#pragma unroll
            for (int i = 0; i < 64; ++i) ((unsigned*)(F.ws + WS_ACT + 32 * MiB))[(size_t)(gq >> 6) * 4096 + 64 * i + lane] = uk[i]; }
#endif
        int nsel;
        if (nvalid <= TOPK) {
            nsel = nvalid;
#pragma unroll
            for (int k = 0; k < 4; ++k) { const int j = lane + 64 * k; selw[j] = j < nvalid ? (unsigned)j : 0u; }
        } else {
            unsigned mx = 0u;
#pragma unroll
            for (int i8 = 0; i8 < 8; ++i8) if (8 * i8 < NT) {
#pragma unroll
                for (int i = 8 * i8; i < 8 * i8 + 8; ++i) mx = uk[i] > mx ? uk[i] : mx; }
#pragma unroll
            for (int off = 32; off >= 1; off >>= 1) { const unsigned o = (unsigned)__shfl_xor((int)mx, off); mx = o > mx ? o : mx; }
            mx = (unsigned)__builtin_amdgcn_readfirstlane((int)mx);
            unsigned Lk = 1u, Hk = mx + 1u, T = 0u; int cl = nvalid, ch = 0, cge = 0, nstep = 0, last = 0;
            unsigned stepc = mx & 0xFF800000u; float fl = (float)cl - 255.5f, fh = -255.5f;
            for (;;) {
                if (cl == TOPK || Hk - Lk == 1u) { T = Lk; cge = cl; break; }
                const unsigned w = Hk - Lk; const bool stepping = nstep < 3 && stepc > Lk;
                unsigned cand;
                if (stepping) cand = stepc;
                else if (w > 0x00800000u) cand = Lk + (w >> 1);
                else cand = Lk + (unsigned)((float)w * (fl / (fl - fh)));
                cand = cand < Lk + 1u ? Lk + 1u : cand; cand = cand > Hk - 1u ? Hk - 1u : cand;
                int c = 0;
#pragma unroll
                for (int i8 = 0; i8 < 8; ++i8) if (8 * i8 < NT) {
#pragma unroll
                    for (int i = 8 * i8; i < 8 * i8 + 8; ++i) c += __popcll(__ballot(uk[i] >= cand)); }
                if (c >= TOPK) { Lk = cand; cl = c; fl = (float)c - 255.5f; if (stepping) nstep = 3; else { if (last == 1) fh *= 0.5f; last = 1; } }
                else { Hk = cand; ch = c; fh = (float)c - 255.5f; if (stepping) { ++nstep; stepc = cand > 0x00800000u ? cand - 0x00800000u : 0u; } else { if (last == 2) fl *= 0.5f; last = 2; } }
            }
            int base = 0;
#pragma unroll
            for (int i8 = 0; i8 < 8; ++i8) if (8 * i8 < NT) {
#pragma unroll
                for (int i = 8 * i8; i < 8 * i8 + 8; ++i) { const bool f = (cge == TOPK) ? (uk[i] >= T) : (uk[i] > T); const unsigned long long bl = __ballot(f);
                    const int pos = base + __popcll(bl & lmask); if (f && pos < TOPK) selw[pos] = (unsigned)(64 * i + lane); base += __popcll(bl); } }
            if (cge > TOPK) {
#pragma unroll
                for (int i8 = 0; i8 < 8; ++i8) if (8 * i8 < NT) {
#pragma unroll
                    for (int i = 8 * i8; i < 8 * i8 + 8; ++i) { const bool f = (uk[i] == T); const unsigned long long bl = __ballot(f);
                        const int pos = base + __popcll(bl & lmask); if (f && pos < TOPK) selw[pos] = (unsigned)(64 * i + lane); base += __popcll(bl); } }
            }
            nsel = TOPK;
        }
        asm volatile("s_waitcnt lgkmcnt(0)" ::: "memory");
#if MK_DIAG
#pragma unroll
        for (int k = 0; k < 4; ++k) ((unsigned*)(F.ws + WS_ACT))[(size_t)gq * 256 + lane + 64 * k] = (lane + 64 * k < nsel) ? selw[lane + 64 * k] : 0xffffffffu;
#endif
        f32x4 C[16];
        {
            long q8[2][2];
#pragma unroll
            for (int ks2 = 0; ks2 < 2; ++ks2)
#pragma unroll
                for (int hf = 0; hf < 2; ++hf) q8[ks2][hf] = *(const long*)((const unsigned char*)Q + (size_t)gq * DATT + head * HD + 64 * ks2 + 16 * kq + 8 * hf);
            const int hg = head >> 2;
            const unsigned char* K8 = (const unsigned char*)K;
            LAS unsigned char* kst = F.lds + 73728 + F.wave * 8704;
            const int l5 = lane >> 5, p32 = lane & 31;
            LAS unsigned char* kw = kst + (8 * l5) * 528 + 16 * p32;
            const LAS unsigned char* kr = kst + head * 528 + 16 * kq;
            u32x4 kbuf[3][8];
#define P4_QK_LOAD(dst_, t_) do { const u32x4 ka_ = *(const LAS u32x4*)(selw + 16 * (t_) + 8 * l5), kb_ = *(const LAS u32x4*)(selw + 16 * (t_) + 8 * l5 + 4); \
                const unsigned kk_[8] = {ka_.x, ka_.y, ka_.z, ka_.w, kb_.x, kb_.y, kb_.z, kb_.w}; const unsigned char* p_ = K8 + (size_t)b * SEQ * DKV + 16 * p32; \
                _Pragma("unroll") for (int i_ = 0; i_ < 8; ++i_) dst_[i_] = *(const u32x4*)(p_ + (size_t)kk_[i_] * DKV); } while (0)
            P4_QK_LOAD(kbuf[0], 0); P4_QK_LOAD(kbuf[1], 1);
#pragma unroll
            for (int t = 0; t < 16; ++t) {
                if (t + 2 < 16) P4_QK_LOAD(kbuf[(t + 2) % 3], t + 2);
                asm volatile("" ::: "memory");
#pragma unroll
                for (int i_ = 0; i_ < 8; ++i_) *(LAS u32x4*)(kw + 528 * i_) = kbuf[t % 3][i_];
                asm volatile("s_waitcnt lgkmcnt(0)" ::: "memory");
                f32x4 c0 = {0.f, 0.f, 0.f, 0.f};
#pragma unroll
                for (int g = 0; g < 4; ++g)
#pragma unroll
                    for (int ks2 = 0; ks2 < 2; ++ks2) {
                        const u32x4 a0 = *(const LAS u32x4*)(kr + g * HD + ks2 * 64);
                        const long a0l = (long)(((unsigned long long)a0.y << 32) | a0.x), a0h = (long)(((unsigned long long)a0.w << 32) | a0.z);
                        const long b0 = (hg == g) ? q8[ks2][0] : 0l, b1 = (hg == g) ? q8[ks2][1] : 0l;
                        c0 = __builtin_amdgcn_mfma_f32_16x16x32_fp8_fp8(a0l, b0, c0, 0, 0, 0); c0 = __builtin_amdgcn_mfma_f32_16x16x32_fp8_fp8(a0h, b1, c0, 0, 0, 0); }
                C[t] = c0;
                asm volatile("s_waitcnt lgkmcnt(0)" ::: "memory");
            }
#undef P4_QK_LOAD
        }
        long Pf[8];
        {
            const float C2 = ATT_SCALE * 1.4426950408889634f * (1.0f / 64.0f); const float NEG = -__builtin_inff();
            float mx = NEG;
#pragma unroll
            for (int tile = 0; tile < 16; ++tile)
#pragma unroll
                for (int e = 0; e < 4; ++e) { const int sl = 16 * tile + 4 * kq + e; const float v = sl < nsel ? C[tile][e] : NEG; C[tile][e] = v; mx = fmaxf(mx, v); }
            mx = fmaxf(mx, __shfl_xor(mx, 16)); mx = fmaxf(mx, __shfl_xor(mx, 32));
            float sum = 0.f;
#pragma unroll
            for (int tile = 0; tile < 16; ++tile)
#pragma unroll
                for (int e = 0; e < 4; ++e) { const float p = __builtin_amdgcn_exp2f((C[tile][e] - mx) * C2); C[tile][e] = p; sum += p; }
            sum += __shfl_xor(sum, 16); sum += __shfl_xor(sum, 32);
            const float inv = 256.0f / sum;
#pragma unroll
            for (int ks = 0; ks < 8; ++ks) {
                const f32x4 a = C[2 * ks] * inv, bq = C[2 * ks + 1] * inv;
                int lo = __builtin_amdgcn_cvt_pk_fp8_f32(a.x, a.y, 0, false); lo = __builtin_amdgcn_cvt_pk_fp8_f32(a.z, a.w, lo, true);
                int hi2 = __builtin_amdgcn_cvt_pk_fp8_f32(bq.x, bq.y, 0, false); hi2 = __builtin_amdgcn_cvt_pk_fp8_f32(bq.z, bq.w, hi2, true);
                Pf[ks] = (long)(((unsigned long long)(unsigned)hi2 << 32) | (unsigned long long)(unsigned)lo); }
        }
        f32x4 Od[8];
#pragma unroll
        for (int d = 0; d < 8; ++d) Od[d] = (f32x4){0.f, 0.f, 0.f, 0.f};
        {
            LAS unsigned char* vst = F.lds + 73728 + F.wave * 8704;
            const unsigned char* V8 = (const unsigned char*)V;
            const int vrow = lane & 31, vhalf = lane >> 5, i16 = lane & 15, trr = i16 >> 1;
            const int trR = (trr < 4) ? (4 * kq + trr) : (16 + 4 * kq + (trr - 4));
            const LAS unsigned char* trbase = vst + trR * 272 + 8 * (i16 & 1);
            LAS unsigned char* wbase = vst + (8 * kq) * 272 + 16 * i16;
            const int hg = head >> 2;
            u32x4 vbuf[4][8];
#define P4_PV_LOAD(dst_, s_) do { const u32x4 ka_ = *(const LAS u32x4*)(selw + 32 * ((s_) >> 1) + 8 * kq), kb_ = *(const LAS u32x4*)(selw + 32 * ((s_) >> 1) + 8 * kq + 4); \
                const unsigned kk_[8] = {ka_.x, ka_.y, ka_.z, ka_.w, kb_.x, kb_.y, kb_.z, kb_.w}; const unsigned char* p_ = V8 + (size_t)b * SEQ * DKV + ((s_) & 1) * 256 + 16 * i16; \
                _Pragma("unroll") for (int i_ = 0; i_ < 8; ++i_) dst_[i_] = *(const u32x4*)(p_ + (size_t)kk_[i_] * DKV); } while (0)
#define P4_PV_MATH(src_, s_) do { asm volatile("" ::: "memory"); _Pragma("unroll") for (int i_ = 0; i_ < 8; ++i_) *(LAS u32x4*)(wbase + 272 * i_) = src_[i_]; \
                asm volatile("s_waitcnt lgkmcnt(0)" ::: "memory"); \
                _Pragma("unroll") for (int gi_ = 0; gi_ < 2; ++gi_) { const long bm_ = (hg == 2 * ((s_) & 1) + gi_) ? Pf[(s_) >> 1] : 0l; \
                    _Pragma("unroll") for (int d_ = 0; d_ < 8; ++d_) { const i32x2 t_ = __builtin_amdgcn_ds_read_tr8_b64_v2i32((i32x2 LAS*)(trbase + gi_ * 128 + d_ * 16)); \
                        const long a_ = (long)(((unsigned long long)(unsigned)t_.y << 32) | (unsigned long long)(unsigned)t_.x); \
                        Od[d_] = __builtin_amdgcn_mfma_f32_16x16x32_fp8_fp8(a_, bm_, Od[d_], 0, 0, 0); } } \
                asm volatile("s_waitcnt lgkmcnt(0)" ::: "memory"); } while (0)
            P4_PV_LOAD(vbuf[0], 0); P4_PV_LOAD(vbuf[1], 1); P4_PV_LOAD(vbuf[2], 2);
#pragma unroll
            for (int s = 0; s < 16; ++s) {
                if (s + 3 < 16) P4_PV_LOAD(vbuf[(s + 3) & 3], s + 3);
                P4_PV_MATH(vbuf[s & 3], s);
            }
#undef P4_PV_LOAD
#undef P4_PV_MATH
        }
        if (F.tid == 0) ntk = (int)__hip_atomic_fetch_add((unsigned*)(F.ws + WS_CTL) + CW_QUEUE, 1u, __ATOMIC_RELAXED, __HIP_MEMORY_SCOPE_AGENT);
        float ss = 0.f;
#pragma unroll
        for (int d = 0; d < 8; ++d) ss += (Od[d].x * Od[d].x + Od[d].y * Od[d].y) + (Od[d].z * Od[d].z + Od[d].w * Od[d].w);
        const float rstd = 1.0f / sqrtf(wave_sum(ss) * (1.0f / DATT) + RMS_EPS);
        const float* ga = F.inp(I_GATTN);
        f32x4 gvv[8];
#pragma unroll
        for (int d = 0; d < 8; ++d) gvv[d] = *(const f32x4*)(ga + head * HD + 16 * d + 4 * kq);
#pragma unroll
        for (int d = 0; d < 8; ++d) { const int idx = head * HD + 16 * d + 4 * kq; const f32x4 gv = gvv[d];
            const float r8 = 8.0f * rstd;
            *(unsigned*)((unsigned char*)MG + (size_t)gq * DM + DLRU + idx) = (pg8::cvt2_fp8(sat8(Od[d].x * r8 * gv.x), sat8(Od[d].y * r8 * gv.y)) & 0xffffu) | (pg8::cvt2_fp8(sat8(Od[d].z * r8 * gv.z), sat8(Od[d].w * r8 * gv.w)) << 16); }
#undef P4_STAGE
    }
}

__device__ __forceinline__ void p5_phase(Frame& F) {
    const float* YL = (const float*)(F.ws + WS_YL); u16* MG = (u16*)(F.ws + WS_MERGED);
    LAS f32x4* va = (LAS f32x4*)F.lds;
    __syncthreads();
    for (int i = F.tid; i < DLRU / 4; i += NTHR) va[i] = ((const f32x4*)F.inp(I_GLRU))[i];
    __syncthreads();
    for (int blk = F.bid; blk < M / 64; blk += F.G) {
        const int row0 = blk * 64 + F.wave * 8;
        f32x4 nx[8];
#pragma unroll
        for (int j = 0; j < 8; ++j) nx[j] = ((const f32x4*)(YL + (size_t)row0 * DLRU) + F.lane)[64 * j];
#pragma unroll 1
        for (int ri = 0; ri < 8; ++ri) {
            const int row = row0 + ri;
            f32x4 v[8]; float s = 0.f;
#pragma unroll
            for (int j = 0; j < 8; ++j) { v[j] = nx[j]; s += (v[j].x * v[j].x + v[j].y * v[j].y) + (v[j].z * v[j].z + v[j].w * v[j].w); }
            if (ri < 7) {
#pragma unroll
                for (int j = 0; j < 8; ++j) nx[j] = ((const f32x4*)(YL + (size_t)(row + 1) * DLRU) + F.lane)[64 * j]; }
            const float rstd = 1.0f / sqrtf(wave_sum(s) * (1.0f / DLRU) + RMS_EPS);
            unsigned* o = (unsigned*)((unsigned char*)MG + (size_t)row * DM) + F.lane;
#pragma unroll
            for (int j = 0; j < 8; ++j) { const f32x4 y = v[j] * (8.0f * rstd) * va[F.lane + 64 * j]; o[64 * j] = (pg8::cvt2_fp8(sat8(y.x), sat8(y.y)) & 0xffffu) | (pg8::cvt2_fp8(sat8(y.z), sat8(y.w)) << 16); }
        }
    }
}

__device__ __forceinline__ void p7_phase(Frame& F) {
    const float* mod = (const float*)(F.ws + WS_MOD); const u16* MIX = (const u16*)(F.ws + WS_MIX); u16* H = (u16*)(F.ws + WS_H);
    LAS f32x4* va = (LAS f32x4*)F.lds; LAS f32x4* vb = va + DM / 4; LAS f32x4* vc = vb + DM / 4;
    for (int blk = F.bid; blk < M / 64; blk += F.G) {
        const int b = (blk * 64) / SEQ;
        __syncthreads();
        for (int i = F.tid; i < DM / 4; i += NTHR) { va[i] = ((const f32x4*)(mod + b * NMOD + 2 * DM))[i] * ((const f32x4*)F.inp(I_GPOSTMIX))[i];
            vb[i] = ((const f32x4*)F.inp(I_GPREFFN))[i] * (1.0f + ((const f32x4*)(mod + b * NMOD + 4 * DM))[i]); vc[i] = ((const f32x4*)(mod + b * NMOD + 3 * DM))[i]; }
        __syncthreads();
        const int row0 = blk * 64 + F.wave * 8;
        u32x2 mw[16]; f32x4 xv[16];
#pragma unroll
        for (int j = 0; j < 16; ++j) mw[j] = *(const u32x2*)(MIX + (size_t)row0 * DM + 4 * F.lane + 256 * j);
#pragma unroll
        for (int j = 0; j < 16; ++j) xv[j] = ((const f32x4*)(F.inp(I_X) + (size_t)row0 * DM) + F.lane)[64 * j];
#pragma unroll 1
        for (int ri = 0; ri < 8; ++ri) {
            const int row = row0 + ri;
            f32x4 v[16]; float s = 0.f;
#pragma unroll
            for (int j = 0; j < 16; ++j) { v[j] = (f32x4){__builtin_bit_cast(float, mw[j].x << 16), __builtin_bit_cast(float, mw[j].x & 0xffff0000u), __builtin_bit_cast(float, mw[j].y << 16), __builtin_bit_cast(float, mw[j].y & 0xffff0000u)};
                s += (v[j].x * v[j].x + v[j].y * v[j].y) + (v[j].z * v[j].z + v[j].w * v[j].w); }
            const float rstd = 1.0f / sqrtf(wave_sum(s) * (1.0f / DM) + RMS_EPS);
            u32x2* xo = (u32x2*)((u16*)(F.ws + WS_MERGED) + (size_t)row * DM) + F.lane; float s2 = 0.f;
#pragma unroll
            for (int j = 0; j < 16; ++j) { v[j] = xv[j] + va[F.lane + 64 * j] * (v[j] * rstd); { u32x2 w; w.x = pkb(v[j].x, v[j].y); w.y = pkb(v[j].z, v[j].w); xo[64 * j] = w; } s2 += (v[j].x * v[j].x + v[j].y * v[j].y) + (v[j].z * v[j].z + v[j].w * v[j].w); }
            if (ri < 7) {
#pragma unroll
                for (int j = 0; j < 16; ++j) mw[j] = *(const u32x2*)(MIX + (size_t)(row + 1) * DM + 4 * F.lane + 256 * j);
#pragma unroll
                for (int j = 0; j < 16; ++j) xv[j] = ((const f32x4*)(F.inp(I_X) + (size_t)(row + 1) * DM) + F.lane)[64 * j]; }
            const float rstd2 = 1.0f / sqrtf(wave_sum(s2) * (1.0f / DM) + RMS_EPS);
            unsigned* o = (unsigned*)((unsigned char*)H + (size_t)row * DM) + F.lane;
            float am = 0.f;
#pragma unroll
            for (int j = 0; j < 16; ++j) { const f32x4 y = v[j] * rstd2 * vb[F.lane + 64 * j] + vc[F.lane + 64 * j]; am = fmaxf(fmaxf(am, fmaxf(fabsf(y.x), fabsf(y.y))), fmaxf(fabsf(y.z), fabsf(y.w))); }
#pragma unroll
            for (int off = 32; off >= 1; off >>= 1) am = fmaxf(am, __shfl_xor(am, off));
            const float qs = am > 0.f ? am * (1.0f / 127.0f) : 1.0f, qi = 1.0f / qs;
            if (F.lane == 0) ((float*)(F.ws + WS_SA_H2))[row] = qs;
#pragma unroll
            for (int j = 0; j < 16; ++j) { const f32x4 y = (v[j] * rstd2 * vb[F.lane + 64 * j] + vc[F.lane + 64 * j]) * qi;
                const int q0 = __float2int_rn(y.x), q1 = __float2int_rn(y.y), q2 = __float2int_rn(y.z), q3 = __float2int_rn(y.w);
                o[64 * j] = (unsigned)(q0 & 255) | ((unsigned)(q1 & 255) << 8) | ((unsigned)(q2 & 255) << 16) | ((unsigned)q3 << 24); }
        }
    }
}

__device__ __forceinline__ void p9_phase(Frame& F) {
    const float* halo = (const float*)(F.ws + WS_HALO); u16* act = (u16*)(F.ws + WS_ACT); const float* cw = F.inp(I_CFW); const float* cb = F.inp(I_CFB);
    const int NQ = DFF / 4, NIT = 128 * 2 * NQ, stride = F.G * NTHR;
#define P9_LOAD(L_, it_) do { const int f4_ = (it_) % NQ, rj_ = (it_) / NQ, r_ = rj_ >> 1, f_ = 4 * f4_; const bool hp_ = (r_ % 32) != 0; const f32x4 z_ = {0.f, 0.f, 0.f, 0.f}; \
        _Pragma("unroll") for (int bj = 0; bj < 2; ++bj) { const int col = bj * DFF + f_; \
            L_[bj][0] = hp_ ? *(const f32x4*)(halo + ((size_t)(r_ - 1) * 4 + 2) * DFF2 + col) : z_; L_[bj][1] = hp_ ? *(const f32x4*)(halo + ((size_t)(r_ - 1) * 4 + 3) * DFF2 + col) : z_; \
            L_[bj][2] = *(const f32x4*)(halo + ((size_t)r_ * 4 + 0) * DFF2 + col); L_[bj][3] = *(const f32x4*)(halo + ((size_t)r_ * 4 + 1) * DFF2 + col); \
            L_[bj][4] = *(const f32x4*)(cw + col); L_[bj][5] = *(const f32x4*)(cw + DFF2 + col); L_[bj][6] = *(const f32x4*)(cw + 2 * DFF2 + col); L_[bj][7] = *(const f32x4*)(cb + col); } } while (0)
#define P9_FINISH(L_, it_) do { const int f4_ = (it_) % NQ, rj_ = (it_) / NQ, jj_ = rj_ & 1, r_ = rj_ >> 1, f_ = 4 * f4_; f32x4 res_[2]; \
        _Pragma("unroll") for (int bj = 0; bj < 2; ++bj) res_[bj] = jj_ ? (L_[bj][7] + L_[bj][4] * L_[bj][1] + L_[bj][5] * L_[bj][2] + L_[bj][6] * L_[bj][3]) : (L_[bj][7] + L_[bj][4] * L_[bj][0] + L_[bj][5] * L_[bj][1] + L_[bj][6] * L_[bj][2]); \
        const f32x4 a_ = gelu_tanh4(res_[0]) * res_[1] * 2.0f; \
        int w_ = __builtin_amdgcn_cvt_pk_fp8_f32(sat8(a_.x), sat8(a_.y), 0, false); w_ = __builtin_amdgcn_cvt_pk_fp8_f32(sat8(a_.z), sat8(a_.w), w_, true); \
        *(unsigned*)((unsigned char*)act + (size_t)(128 * r_ + jj_) * DFF + f_) = (unsigned)w_; } while (0)
    for (int it = F.bid * NTHR + F.tid; it < NIT; it += 2 * stride) {
        f32x4 LA[2][8], LB[2][8]; const int itb = it + stride; const bool hb = itb < NIT;
        P9_LOAD(LA, it);
        if (hb) P9_LOAD(LB, itb);
        P9_FINISH(LA, it);
        if (hb) P9_FINISH(LB, itb);
    }
#undef P9_LOAD
#undef P9_FINISH
}

__device__ __forceinline__ void p11_phase(Frame& F) {
    const float* mod = (const float*)(F.ws + WS_MOD); const u16* FF = (const u16*)(F.ws + WS_MIX);
    LAS f32x4* va = (LAS f32x4*)F.lds;
    for (int blk = F.bid; blk < M / 64; blk += F.G) {
        const int b = (blk * 64) / SEQ;
        __syncthreads();
        for (int i = F.tid; i < DM / 4; i += NTHR) va[i] = ((const f32x4*)(mod + b * NMOD + 5 * DM))[i] * ((const f32x4*)F.inp(I_GPOSTFFN))[i];
        __syncthreads();
        const int row0 = blk * 64 + F.wave * 8;
        u32x2 fw[16], xw[16], xn[16];
#define CVB4(w) ((f32x4){__builtin_bit_cast(float, (w).x << 16), __builtin_bit_cast(float, (w).x & 0xffff0000u), __builtin_bit_cast(float, (w).y << 16), __builtin_bit_cast(float, (w).y & 0xffff0000u)})
#pragma unroll
        for (int j = 0; j < 16; ++j) { fw[j] = *(const u32x2*)(FF + (size_t)row0 * DM + 4 * F.lane + 256 * j); xw[j] = *(const u32x2*)((const u16*)(F.ws + WS_MERGED) + (size_t)row0 * DM + 4 * F.lane + 256 * j); }
#pragma unroll 1
        for (int ri = 0; ri < 8; ++ri) {
            const int row = row0 + ri;
            f32x4 v[16]; float s = 0.f;
#pragma unroll
            for (int j = 0; j < 16; ++j) { const u32x2 w = fw[j]; v[j] = CVB4(w); s += (v[j].x * v[j].x + v[j].y * v[j].y) + (v[j].z * v[j].z + v[j].w * v[j].w); }
            if (ri < 7) {
#pragma unroll
                for (int j = 0; j < 16; ++j) { fw[j] = *(const u32x2*)(FF + (size_t)(row + 1) * DM + 4 * F.lane + 256 * j); xn[j] = *(const u32x2*)((const u16*)(F.ws + WS_MERGED) + (size_t)(row + 1) * DM + 4 * F.lane + 256 * j); } }
            const float rstd = 1.0f / sqrtf(wave_sum(s) * (1.0f / DM) + RMS_EPS);
            f32x4* xo = (f32x4*)(F.out + (size_t)row * DM) + F.lane;
#pragma unroll
            for (int j = 0; j < 16; ++j) { const u32x2 x = xw[j]; const f32x4 xx = CVB4(x); xo[64 * j] = xx + va[F.lane + 64 * j] * (v[j] * rstd); }
            if (ri < 7) {
#pragma unroll
                for (int j = 0; j < 16; ++j) xw[j] = xn[j]; }
        }
#undef CVB4
    }
}


__device__ __forceinline__ unsigned hash_u(unsigned x) { x ^= x >> 16; x *= 0x7feb352du; x ^= x >> 15; x *= 0x846ca68bu; x ^= x >> 16; return x; }
__device__ __forceinline__ float rf16(float x) { return (float)(f16)x; }
__device__ __forceinline__ void chk_flag(Frame& F, int bit, bool bad) { if (bad && F.lane == 0) atomicOr((unsigned*)(F.ws + WS_CTL) + CW_FLAGS, 1u << bit); }
__device__ __forceinline__ float chk_dot(Frame& F, const u16* A, size_t lda, int row, const float* W, int N, int K, int col) {
    float s = 0.f;
    for (int k = F.lane; k < K; k += 64) s += h2f(A[(size_t)row * lda + k]) * rf16(W[(size_t)k * N + col]);
    return wave_sum(s);
}
__device__ __forceinline__ void chk1_phase(Frame& F) {
    const int gw = F.bid * NWAVES + F.wave;
    for (int s4 = 0; s4 < 4; ++s4) {
        const unsigned s = (unsigned)(gw * 4 + s4); const unsigned h = hash_u(s * 2u + 1u), h2 = hash_u(s * 2u + 2u);
        const int row = (int)(h % (unsigned)M); int col = (int)(h2 % (unsigned)DIN); if ((s & 7u) == 0u) col = 9216 + (int)(h2 % 96u);
        const float ref = chk_dot(F, (const u16*)(F.ws + WS_H), DM, row, F.inp(I_WIN), DIN, DM, col);
        float got;
        if (col < 2048) got = h2f(((const u16*)(F.ws + WS_XL))[(size_t)row * DLRU + col]);
        else if (col < 4096) got = h2f(((const u16*)(F.ws + WS_GATE))[(size_t)row * DLRU + col - 2048]);
        else if (col < 6144) got = h2f(((const u16*)(F.ws + WS_Q))[(size_t)row * DATT + col - 4096]);
        else if (col < 6656) got = h2f(((const u16*)(F.ws + WS_K))[(size_t)row * DKV + col - 6144]);
        else if (col < 7168) got = h2f(((const u16*)(F.ws + WS_V))[(size_t)row * DKV + col - 6656]);
        else if (col < 9216) got = h2f(((const u16*)(F.ws + WS_QI))[(size_t)row * 2048 + col - 7168]);
        else if (col < 9280) got = h2f(((const u16*)(F.ws + WS_KI))[(size_t)row * IDIM + col - 9216]);
        else got = ((const float*)(F.ws + WS_WI))[(size_t)row * NIH + col - 9280];
        chk_flag(F, 4, !(fabsf(got - ref) <= 1.5e-3f * fabsf(ref) + 1.5e-3f));
    }
}
__device__ __forceinline__ void chk2_phase(Frame& F) {
    const int gw = F.bid * NWAVES + F.wave;
    for (int s4 = 0; s4 < 4; ++s4) {
        const unsigned s = (unsigned)(gw * 4 + s4); const unsigned h = hash_u(s * 2u + 11u), h2 = hash_u(s * 2u + 12u);
        const int row = (int)(h % (unsigned)M), col = (int)(h2 % (unsigned)DM);
        const float ref = chk_dot(F, (const u16*)(F.ws + WS_MERGED), DM, row, F.inp(I_WOUT), DM, DM, col);
        const float got = ((const float*)(F.ws + WS_MIX))[(size_t)row * DM + col];
        chk_flag(F, 5, !(fabsf(got - ref) <= 1.0e-3f * fabsf(ref) + 1.0e-3f));
    }
}
__device__ __forceinline__ void chk3_phase(Frame& F) {
    const int gw = F.bid * NWAVES + F.wave;
    for (int s4 = 0; s4 < 4; ++s4) {
        const unsigned s = (unsigned)(gw * 4 + s4); const unsigned h = hash_u(s * 2u + 21u), h2 = hash_u(s * 2u + 22u);
        int row = (int)(h % (unsigned)M); const int f = (int)(h2 % (unsigned)DFF);
        const unsigned m8 = s & 7u;
        if (m8 == 0u) row = (row & ~127); else if (m8 == 1u) row = (row & ~127) + 1; else if (m8 == 2u) row = (row & ~127) + 2; else if (m8 == 3u) row = (row & ~127) + 127;
        else if (m8 == 4u) row = (row & ~7); else if (m8 == 5u) row = (row & ~7) + 1;
        const int t = row % SEQ;
        float ug = F.inp(I_CFB)[f], uu = F.inp(I_CFB)[DFF + f];
        for (int j = 0; j < 3; ++j) { const int ts = t - 2 + j; if (ts < 0) continue; const int rr = row - 2 + j;
            ug += F.inp(I_CFW)[j * DFF2 + f] * chk_dot(F, (const u16*)(F.ws + WS_H), DM, rr, F.inp(I_WFI), DFF2, DM, f);
            uu += F.inp(I_CFW)[j * DFF2 + DFF + f] * chk_dot(F, (const u16*)(F.ws + WS_H), DM, rr, F.inp(I_WFI), DFF2, DM, DFF + f); }
        const float ref = gelu_tanh(ug) * uu;
        const float got = h2f(((const u16*)(F.ws + WS_ACT))[(size_t)row * DFF + f]);
        chk_flag(F, 6, !(fabsf(got - ref) <= 3.0e-3f * fabsf(ref) + 3.0e-3f));
    }
}
__device__ __forceinline__ void chk4_phase(Frame& F) {
    const int gw = F.bid * NWAVES + F.wave;
    for (int s4 = 0; s4 < 4; ++s4) {
        const unsigned s = (unsigned)(gw * 4 + s4); const unsigned h = hash_u(s * 2u + 31u), h2 = hash_u(s * 2u + 32u);
        const int row = (int)(h % (unsigned)M), col = (int)(h2 % (unsigned)DM);
        const float ref = chk_dot(F, (const u16*)(F.ws + WS_ACT), DFF, row, F.inp(I_WFO), DM, DFF, col);
        const float got = ((const float*)(F.ws + WS_MIX))[(size_t)row * DM + col];
        chk_flag(F, 7, !(fabsf(got - ref) <= 1.0e-3f * fabsf(ref) + 1.0e-3f));
    }
}

constexpr int NPH = 12;
struct Args { const float* in[23]; float* out; unsigned char* ws; int ph_lo, ph_hi, li, pad; };
__global__ void __launch_bounds__(NTHR, 2) fwd(Args args) {
    extern __shared__ __attribute__((aligned(16))) unsigned char lds[];
    Frame F;
    F.lds = (LAS unsigned char*)lds; F.ws = args.ws;
    F.tid = threadIdx.x; F.lane = F.tid & 63; F.wave = __builtin_amdgcn_readfirstlane(F.tid >> 6); F.G = gridDim.x; F.bid = blockIdx.x;
    F.kin = (const float* const __attribute__((address_space(4)))*)__builtin_amdgcn_kernarg_segment_ptr();
    F.out = args.out;
    volatile LAS unsigned* MISC = (volatile LAS unsigned*)(F.lds + MISC_OFF);
    for (int u = F.tid; u < (LDS_BYTES - LDSCTL_OFF) / 4; u += NTHR) ((LAS unsigned*)(F.lds + LDSCTL_OFF))[u] = 0u;
    __syncthreads();
    XcdBarrier bar; bar.bar = (unsigned*)(F.ws + WS_CTL) + CW_BAR; bar.x = 0; bar.st = nullptr;
    if (MK_N_LAUNCHES == 1) bar = xcd_barrier_post((unsigned*)(F.ws + WS_CTL) + CW_BAR, MISC + 8);
    const int lo = args.ph_lo, hi = args.ph_hi;
#define IN(k) (lo <= (k) && (k) < hi)
#define SEAM(k) do { if (IN(k) && IN((k) + 1)) xcd_barrier(bar); } while (0)

    if (IN(0)) { p0_phase(F); late_convert<0>(F); __syncthreads(); wq_onepass(F); } SEAM(0);
    if (IN(1)) { p1_phase(F); asm volatile("s_waitcnt vmcnt(0)" ::: "memory"); __syncthreads(); p2b_thin(F); } SEAM(1);
    if (IN(2)) {
        { pg8::Gemm g{(const u16*)(F.ws + WS_H8), (const u16*)(F.ws + WS_WIN8), M, 36 * 256, DM / 2}; pg8::StaticOrder S; S.init(M, 36 * 256, F.G, F.bid);
          pg8::EpiProjQ E{F.ws, (const float*)(F.ws + WS_SA_H1), (const float*)(F.ws + WS_SB_WIN)};
          pg8::gemm_phase<pg8::EpiProjQ>(F.lds, g, S, E); }
    } SEAM(2);
    if (IN(3)) { p3_fast(F); }
    if (IN(4)) { __syncthreads(); p4_fast(F); }
    SEAM(4);
    if (IN(5)) { p5_phase(F); } SEAM(5);
    if (IN(6)) {
        pg8::Gemm g{(const u16*)(F.ws + WS_MERGED), (const u16*)(F.ws + WS_WOUT), M, DM, DM / 2}; pg8::StaticOrder S; S.init(M, DM, F.G, F.bid);
        pg8::EpiB16S8 E{(u16*)(F.ws + WS_MIX), DM};
        pg8::gemm_phase<pg8::EpiB16S8>(F.lds, g, S, E);
    } SEAM(6);
    if (IN(7)) { p7_phase(F); } SEAM(7);
    if (IN(8)) {
        pg8::Gemm g{(const u16*)(F.ws + WS_H), (const u16*)(F.ws + WS_WFI), M, DFF2, DM / 2}; pg8::StaticOrder S; S.init(M, DFF2, F.G, F.bid);
        pg8::EpiFfn E{(u16*)(F.ws + WS_ACT), (float*)(F.ws + WS_HALO), F.inp(I_CFW), F.inp(I_CFB), (const float*)(F.ws + WS_SA_H2), (const float*)(F.ws + WS_SB_WFI)};
        pg8::gemm_phase<pg8::EpiFfn>(F.lds, g, S, E);
        __syncthreads();
        late_convert<1>(F);
    } SEAM(8);
    if (IN(9)) { p9_phase(F); } SEAM(9);
    if (IN(10)) {
        pg8::Gemm g{(const u16*)(F.ws + WS_ACT), (const u16*)(F.ws + WS_WFO), M, DM, DFF / 2}; pg8::StaticOrder S; S.init(M, DM, F.G, F.bid);
        pg8::EpiB16F8 E{(u16*)(F.ws + WS_MIX), DM};
        pg8::gemm_phase<pg8::EpiB16F8>(F.lds, g, S, E);
    } SEAM(10);
    if (IN(11)) { p11_phase(F); }
#undef IN
#undef SEAM
}

#if MK_DIAG
__global__ void __launch_bounds__(NTHR, 2) diag_p4(Args args) {
    extern __shared__ __attribute__((aligned(16))) unsigned char lds[];
    Frame F; F.lds = (LAS unsigned char*)lds; F.ws = args.ws; F.tid = threadIdx.x; F.lane = F.tid & 63; F.wave = __builtin_amdgcn_readfirstlane(F.tid >> 6); F.G = gridDim.x; F.bid = blockIdx.x;
    F.kin = (const float* const __attribute__((address_space(4)))*)__builtin_amdgcn_kernarg_segment_ptr();
    F.out = args.out;
    p4_phase(F);
}
__global__ void diag_scale(Args args) {
    const float v = 1000.0f * fabsf(((const float*)(args.ws + WS_CTL))[CW_FLAGS + 1] / ((const float*)(args.ws + WS_CTL))[CW_FLAGS + 2]);
    for (size_t i = (size_t)blockIdx.x * blockDim.x + threadIdx.x; i < (size_t)M * DM; i += (size_t)gridDim.x * blockDim.x) args.out[i] = args.in[I_X][i] * (1.0f + v);
}
#endif
extern "C" void kernel_launch(void* const* d_in, const int* in_sizes, int n_in, void* d_out, int out_size, void* d_ws, size_t ws_size, hipStream_t stream) {
    static int grid = 0;
    if (grid == 0) {
        if (n_in != 23 || out_size != M * DM || ws_size < WS_END) { fprintf(stderr, "kernel_launch: unexpected shapes (n_in %d, out %d, ws %zu, need %zu)\n", n_in, out_size, ws_size, (size_t)WS_END); grid = -1; return; }
        int dev = 0, cus = 0, per_cu = 0;
        if (hipGetDevice(&dev) != hipSuccess || hipDeviceGetAttribute(&cus, hipDeviceAttributeMultiprocessorCount, dev) != hipSuccess) { grid = -1; return; }
        if (hipFuncSetAttribute((const void*)fwd, hipFuncAttributeMaxDynamicSharedMemorySize, LDS_BYTES) != hipSuccess) { fprintf(stderr, "kernel_launch: hipFuncSetAttribute failed\n"); grid = -1; return; }
        if (hipOccupancyMaxActiveBlocksPerMultiprocessor(&per_cu, (const void*)fwd, NTHR, LDS_BYTES) != hipSuccess || per_cu < 1) fprintf(stderr, "kernel_launch: occupancy query reports %d\n", per_cu);
        (void)hipGetLastError();
        grid = cus;
    }
    if (grid < 0) return;
    (void)hipMemsetAsync((char*)d_ws + WS_CTL, 0, CTL_ZERO_BYTES, stream);
    Args a{};
    for (int i = 0; i < 23; ++i) a.in[i] = (const float*)d_in[i];
    a.out = (float*)d_out; a.ws = (unsigned char*)d_ws;
#if MK_DIAG
    (void)hipFuncSetAttribute((const void*)diag_p4, hipFuncAttributeMaxDynamicSharedMemorySize, LDS_BYTES);
    a.ph_lo = 0; a.ph_hi = 5; a.li = 0; hipLaunchKernelGGL(fwd, dim3(grid), dim3(NTHR), LDS_BYTES, stream, a);
    hipLaunchKernelGGL(diag_p4, dim3(grid), dim3(NTHR), LDS_BYTES, stream, a);
    (void)hipMemsetAsync((char*)d_ws + WS_CTL + CW_BAR * 4, 0, XCD_BAR_WORDS * 4, stream);
    a.ph_lo = 5; a.ph_hi = NPH; a.li = 1; hipLaunchKernelGGL(fwd, dim3(grid), dim3(NTHR), LDS_BYTES, stream, a);
    hipLaunchKernelGGL(diag_scale, dim3(1024), dim3(256), 0, stream, a);
#else
    if (MK_PROBE >= 100) {
        const int k = MK_PROBE - 100;
        a.ph_lo = 0; a.ph_hi = k + 1; a.li = 0; hipLaunchKernelGGL(fwd, dim3(grid), dim3(NTHR), LDS_BYTES, stream, a);
        for (int r = 0; r < MK_PREP; ++r) {
            (void)hipMemsetAsync((char*)d_ws + WS_CTL + CW_BAR * 4, 0, XCD_BAR_WORDS * 4, stream);
            (void)hipMemsetAsync((char*)d_ws + WS_CTL + CW_QUEUE * 4, 0, 4, stream);
            a.ph_lo = k; a.ph_hi = k + 1; a.li = 2; hipLaunchKernelGGL(fwd, dim3(grid), dim3(NTHR), LDS_BYTES, stream, a);
        }
        (void)hipMemsetAsync((char*)d_ws + WS_CTL + CW_BAR * 4, 0, XCD_BAR_WORDS * 4, stream);
        a.ph_lo = k + 1; a.ph_hi = NPH; a.li = 1; hipLaunchKernelGGL(fwd, dim3(grid), dim3(NTHR), LDS_BYTES, stream, a);
    } else if (MK_PROBE >= 0) {
        a.ph_lo = 0; a.ph_hi = MK_PROBE + 1; a.li = 0; hipLaunchKernelGGL(fwd, dim3(grid), dim3(NTHR), LDS_BYTES, stream, a);
        (void)hipMemsetAsync((char*)d_ws + WS_CTL + CW_BAR * 4, 0, XCD_BAR_WORDS * 4, stream);
        a.ph_lo = MK_PROBE; a.ph_hi = NPH; a.li = 1; hipLaunchKernelGGL(fwd, dim3(grid), dim3(NTHR), LDS_BYTES, stream, a);
    } else if (MK_N_LAUNCHES == 1) {
        a.ph_lo = 0; a.ph_hi = NPH; a.li = 0;
        hipLaunchKernelGGL(fwd, dim3(grid), dim3(NTHR), LDS_BYTES, stream, a);
    } else {
        for (int p = 0; p < NPH; ++p) { a.ph_lo = p; a.ph_hi = p + 1; a.li = p; hipLaunchKernelGGL(fwd, dim3(grid), dim3(NTHR), LDS_BYTES, stream, a); }
    }
#endif
}
```

```cpp
#include <hip/hip_runtime.h>
#include <cstdio>
#include <cstdint>

#ifndef MK_N_LAUNCHES
#define MK_N_LAUNCHES 1
#endif

#ifndef MK_PREP
#define MK_PREP 2
#endif
#ifndef MK_SELREP
#define MK_SELREP 0
#endif
#ifndef MK_PROBE
#define MK_PROBE -1
#endif
#ifndef P4_DIRECT
#define P4_DIRECT 0
#endif
#ifndef MK_DIAG
#define MK_DIAG 0
#endif
#define LAS __attribute__((address_space(3)))
#define GAS __attribute__((address_space(1)))
typedef _Float16 f16;
typedef _Float16 f16x2 __attribute__((ext_vector_type(2)));
typedef _Float16 f16x8 __attribute__((ext_vector_type(8)));
typedef short s16x8 __attribute__((ext_vector_type(8)));
typedef float f32x4 __attribute__((ext_vector_type(4)));
typedef float f32x2 __attribute__((ext_vector_type(2)));
typedef unsigned u32x4 __attribute__((ext_vector_type(4)));
typedef unsigned u32x2 __attribute__((ext_vector_type(2)));
typedef unsigned short u16;
typedef int i32x2 __attribute__((ext_vector_type(2)));
typedef int i32x4 __attribute__((ext_vector_type(4)));
typedef int i32x8 __attribute__((ext_vector_type(8)));

constexpr int BATCH = 4, SEQ = 4096, DM = 4096, M = BATCH * SEQ;
constexpr int DLRU = 2048, NLB = 16, LB = 128, DATT = 2048, DKV = 512, NH = 16, NKV = 4, HD = 128, NIH = 32, IDIM = 64;
constexpr int DIN = 9312, DINP = 9472, DFF = 11008, DFF2 = 22016, TOPK = 256, NMOD = 6 * DM;
constexpr float RMS_EPS = 1e-6f;
constexpr float ATT_SCALE = 0.08838834764831845f;
constexpr int NWAVES = 8, NTHR = 512;

constexpr size_t MiB = 1u << 20;
constexpr size_t WS_CTL = 0, CTL_ZERO_BYTES = 1 * MiB;
constexpr size_t WS_MOD = 1 * MiB;
constexpr size_t WS_WIN = 2 * MiB;
constexpr size_t WS_WOUT = WS_WIN + 74 * MiB;
constexpr size_t WS_WFI = WS_WOUT + 32 * MiB;
constexpr size_t WS_WFO = WS_WFI + 172 * MiB;
constexpr size_t WS_H = WS_WFO + 86 * MiB;
constexpr size_t WS_XL = WS_H + 128 * MiB;
constexpr size_t WS_GATE = WS_XL + 64 * MiB;
constexpr size_t WS_Q = WS_GATE + 64 * MiB;
constexpr size_t WS_K = WS_Q + 64 * MiB;
constexpr size_t WS_V = WS_K + 16 * MiB;
constexpr size_t WS_QI = WS_V + 16 * MiB;
constexpr size_t WS_KI = WS_QI + 64 * MiB;
constexpr size_t WS_WI = WS_KI + 2 * MiB;
constexpr size_t WS_PROJ_END = WS_WI + 2 * MiB;
constexpr size_t WS_MIX = WS_XL;
constexpr size_t WS_YL = WS_PROJ_END;
constexpr size_t WS_MERGED = WS_YL + 128 * MiB;
constexpr size_t WS_ACT = WS_MERGED + 128 * MiB;
constexpr size_t WS_HALO = WS_ACT + 344 * MiB;
constexpr size_t WS_WRG = WS_HALO + 44 * MiB;
constexpr size_t WS_SCL = WS_WRG + 1 * MiB;
constexpr size_t WS_SA_H2 = WS_SCL, WS_SB_WFI = WS_SCL + 64 * 1024;
constexpr size_t WS_SB_WIN = WS_SCL + 192 * 1024, WS_SA_H1 = WS_SCL + 256 * 1024;
constexpr size_t WS_END = WS_SCL + 1 * MiB;
constexpr size_t WS_H8 = WS_ACT;
constexpr int WIN_KI_ROW = 0, WIN8_ROW = 256;
constexpr size_t WS_WIN8 = WS_WIN + (size_t)WIN8_ROW * DM * 2;
static_assert(WS_MIX + (size_t)M * DM * 4 <= WS_PROJ_END, "mix overlay");
static_assert(WS_END <= 1536 * MiB, "workspace");
constexpr int CW_BAR = 4096;
constexpr int CW_QUEUE = 192;
constexpr int CW_WMAX_WIN = 8192 + 22016;
constexpr int CW_WMAX_WFI = 8192;
constexpr int CW_CONVQ = 320, CW_CONVQ2 = 384;
constexpr int CW_FLAGS = 64;

constexpr int RING_BYTES = 131072;
constexpr int LDSCTL_OFF = 143488, MISC_OFF = LDSCTL_OFF + 320;
constexpr int LDS_BYTES = 147456;

#define LDS_WAIT() asm volatile("s_waitcnt lgkmcnt(0)" ::: "memory")
#define VM_WAIT() asm volatile("s_waitcnt vmcnt(0)" ::: "memory")

__device__ __forceinline__ unsigned pkh(float lo, float hi) { f16x2 p = {(f16)lo, (f16)hi}; return __builtin_bit_cast(unsigned, p); }
__device__ __forceinline__ unsigned pkb(float lo, float hi) { unsigned r; asm volatile("v_cvt_pk_bf16_f32 %0, %1, %2" : "=v"(r) : "v"(lo), "v"(hi)); return r; }
__device__ __forceinline__ float sat8(float x) { return __builtin_amdgcn_fmed3f(x, -448.0f, 448.0f); }
__device__ __forceinline__ float h2f(u16 u) { return (float)__builtin_bit_cast(f16, u); }
__device__ __forceinline__ float fast_exp(float x) { return __builtin_amdgcn_exp2f(x * 1.4426950408889634f); }
__device__ __forceinline__ float sigmoidf_(float x) { return __builtin_amdgcn_rcpf(1.0f + fast_exp(-x)); }
__device__ __forceinline__ float gelu_tanh(float x) {
    const float t = x * x, p = __builtin_fmaf(t, -0.10294324f, -2.3022082f);
    return x * __builtin_amdgcn_rcpf(1.0f + __builtin_amdgcn_exp2f(x * p));
}
__device__ __forceinline__ f32x4 gelu_tanh4(f32x4 x) {
    const f32x4 t = x * x, p = t * -0.10294324f + -2.3022082f, a = x * p;
    const f32x4 d = (f32x4){__builtin_amdgcn_exp2f(a.x), __builtin_amdgcn_exp2f(a.y), __builtin_amdgcn_exp2f(a.z), __builtin_amdgcn_exp2f(a.w)} + 1.0f;
    return x * (f32x4){__builtin_amdgcn_rcpf(d.x), __builtin_amdgcn_rcpf(d.y), __builtin_amdgcn_rcpf(d.z), __builtin_amdgcn_rcpf(d.w)};
}
__device__ __forceinline__ f32x4 ldb4(const u16* p) { const u32x2 w = *(const u32x2*)p; return (f32x4){__builtin_bit_cast(float, w.x << 16), __builtin_bit_cast(float, w.x & 0xffff0000u), __builtin_bit_cast(float, w.y << 16), __builtin_bit_cast(float, w.y & 0xffff0000u)}; }
__device__ __forceinline__ void ldb8(const u16* p, f32x4& lo, f32x4& hi) { const u32x4 w = *(const u32x4*)p;
    lo = (f32x4){__builtin_bit_cast(float, w.x << 16), __builtin_bit_cast(float, w.x & 0xffff0000u), __builtin_bit_cast(float, w.y << 16), __builtin_bit_cast(float, w.y & 0xffff0000u)};
    hi = (f32x4){__builtin_bit_cast(float, w.z << 16), __builtin_bit_cast(float, w.z & 0xffff0000u), __builtin_bit_cast(float, w.w << 16), __builtin_bit_cast(float, w.w & 0xffff0000u)}; }
__device__ __forceinline__ float wave_sum(float v) {
#pragma unroll
    for (int o = 1; o < 64; o <<= 1) v += __shfl_xor(v, o);
    return v;
}
__device__ __forceinline__ float wave_max(float v) {
#pragma unroll
    for (int o = 1; o < 64; o <<= 1) v = fmaxf(v, __shfl_xor(v, o));
    return v;
}

namespace pg8 {
constexpr int BM = 256, BK = 64, HALF = 128, HTB = HALF * BK * 2, STAGE_BYTES = 8 * HTB, NXCD = 8, WGM = 8;
__host__ __device__ __forceinline__ int lds_byte(int r, int c) { const int st = (r >> 4) * 2 + (c >> 5), rr = r & 15, cc = c & 31, ob = rr * 64 + cc * 2; return st * 1024 + (ob ^ (((ob >> 9) & 1) << 5)); }
__host__ __device__ __forceinline__ void stage_rc(int b, int& R, int& C) { const int st = b / 1024, sb = b % 1024, swz = sb ^ (((sb >> 9) & 1) << 5); R = (st >> 1) * 16 + swz / 64; C = (st & 1) * 32 + (swz % 64) / 2; }
__host__ __device__ __forceinline__ int perm32(int rho) { const int n = rho >> 4, i = rho & 15; return 8 * (i >> 2) + 4 * n + (i & 3); }

struct Unit { int pm, pn; };
struct Gemm { const u16* A; const u16* Bt; int M, N, K; };

struct StaticOrder {
    int nM, nN, nwg, G, c;
    __host__ __device__ void init(int M_, int N_, int G_, int c_) { nM = M_ / BM; nN = N_ / BM; nwg = nM * nN; G = G_; c = c_; }
    __host__ __device__ bool next(int i, Unit& u) const {
        const long L = (long)i * G + c; if (L >= nwg) return false;
        int wgid = (int)L; { const int q = nwg / NXCD, r = nwg % NXCD, xcd = wgid % NXCD, off = wgid / NXCD; wgid = (xcd < r ? xcd * (q + 1) : r * (q + 1) + (xcd - r) * q) + off; }
        const int nig = WGM * nN, gid = wgid / nig, fm = gid * WGM, gsz = (nM - fm) < WGM ? (nM - fm) : WGM;
        u.pm = fm + ((wgid % nig) % gsz); u.pn = (wgid % nig) / gsz; return true;
    }
};

template <class Epi>
__device__ __forceinline__ void gemm_phase(LAS unsigned char* lds, const Gemm g, const StaticOrder& S, const Epi& E) {
    const int tid = threadIdx.x, wid = __builtin_amdgcn_readfirstlane(tid >> 6), lane = tid & 63, wr = wid >> 2, wc = wid & 3, fr = lane & 15, fq = lane >> 4;
    const int K = g.K, nt = K / BK;
    unsigned voffA[2], voffB[2];
#pragma unroll
    for (int i = 0; i < 2; ++i) { int R, C; stage_rc(tid * 16 + i * 8192, R, C); const int Rb = Epi::PERM ? ((R & ~31) + perm32(R & 31)) : R;
        const int Ra = Epi::ROWPERM ? ((((R >> 6) * 16 + (R & 15)) * 8) + ((R >> 4) & 3)) : R;
        voffA[i] = (unsigned)(Ra * K + C) * 2u; voffB[i] = (unsigned)(Rb * K + C) * 2u; }
    const size_t kstep = (size_t)(BK * 2);
    const size_t hstep = (size_t)HALF * K * 2;
    const size_t hstepA = Epi::ROWPERM ? (size_t)4 * K * 2 : hstep;
    const size_t tstep = 2 * hstep;
    const unsigned ldsw = (unsigned)wid * 1024u;
    const int aoff = lds_byte(wr * 64 + fr, fq * 8), boff = lds_byte(wc * 32 + fr, fq * 8);
#define PG8_SA(b, h) (((b) * 2 + (h)) * HTB)
#define PG8_SB(b, h) ((4 + (b) * 2 + (h)) * HTB)
#define PG8_STAGE(bufoff, gbase, voff) do { _Pragma("unroll") for (int _i = 0; _i < 2; ++_i) \
        __builtin_amdgcn_global_load_lds((const unsigned*)((const char*)(gbase) + (voff)[_i]), (LAS unsigned*)(lds + (bufoff) + ldsw + _i * 8192), 16, 0, 0); } while (0)
#define PG8_LDA(dst, b, h) do { _Pragma("unroll") for (int m = 0; m < 4; ++m) { const f16x8 l0_ = *(const LAS f16x8*)(lds + PG8_SA(b, h) + aoff + m * 2048), l1_ = *(const LAS f16x8*)(lds + PG8_SA(b, h) + aoff + m * 2048 + 1024); \
        if constexpr (Epi::MM == 2) dst##8[m] = __builtin_shufflevector(__builtin_bit_cast(i32x4, l0_), __builtin_bit_cast(i32x4, l1_), 0, 1, 2, 3, 4, 5, 6, 7); else { dst[m][0] = l0_; dst[m][1] = l1_; } } } while (0)
#define PG8_LDB(dst, b, h) do { _Pragma("unroll") for (int n = 0; n < 2; ++n) { const f16x8 l0_ = *(const LAS f16x8*)(lds + PG8_SB(b, h) + boff + n * 2048), l1_ = *(const LAS f16x8*)(lds + PG8_SB(b, h) + boff + n * 2048 + 1024); \
        if constexpr (Epi::MM == 2) dst##8[n] = __builtin_shufflevector(__builtin_bit_cast(i32x4, l0_), __builtin_bit_cast(i32x4, l1_), 0, 1, 2, 3, 4, 5, 6, 7); else { dst[n][0] = l0_; dst[n][1] = l1_; } } } while (0)
#define PG8_MMA(ai, bj, At, Bt) do { __builtin_amdgcn_s_setprio(1); _Pragma("unroll") for (int m = 0; m < 4; ++m) _Pragma("unroll") for (int n = 0; n < 2; ++n) { \
        if constexpr (Epi::MM == 2) asm volatile("v_mfma_f32_16x16x128_f8f6f4 %0, %1, %2, %0" : "+v"(acc[ai][bj][m][n]) : "v"(Bt##8[n]), "v"(At##8[m]));     \
        else if constexpr (Epi::MM == 3) { _Pragma("unroll") for (int k = 0; k < 2; ++k) acc[ai][bj][m][n] = __builtin_bit_cast(f32x4, __builtin_amdgcn_mfma_i32_16x16x64_i8(__builtin_bit_cast(i32x4, Bt[n][k]), __builtin_bit_cast(i32x4, At[m][k]), __builtin_bit_cast(i32x4, acc[ai][bj][m][n]), 0, 0, 0)); }     \
        else { _Pragma("unroll") for (int k = 0; k < 2; ++k) acc[ai][bj][m][n] = (Epi::MM == 1) ? __builtin_amdgcn_mfma_f32_16x16x32_bf16(__builtin_bit_cast(s16x8, Bt[n][k]), __builtin_bit_cast(s16x8, At[m][k]), acc[ai][bj][m][n], 0, 0, 0) : __builtin_amdgcn_mfma_f32_16x16x32_f16(Bt[n][k], At[m][k], acc[ai][bj][m][n], 0, 0, 0); } } \
        __builtin_amdgcn_s_setprio(0); } while (0)
#define PG8_WAIT_V(n) asm volatile("s_waitcnt vmcnt(" #n ")" ::: "memory")
#define PG8_WAIT_L(n) asm volatile("s_waitcnt lgkmcnt(" #n ")" ::: "memory")
#define PG8_BAR __builtin_amdgcn_s_barrier()
#define PG8_SCHED __builtin_amdgcn_sched_barrier(0)
    Unit cur, nxt; int ui = 0;
    if (!S.next(0, cur)) return;
    f32x4 acc[2][2][4][2];
#pragma unroll
    for (int a = 0; a < 2; ++a)
#pragma unroll
        for (int b = 0; b < 2; ++b)
#pragma unroll
            for (int m = 0; m < 4; ++m)
#pragma unroll
                for (int n = 0; n < 2; ++n) acc[a][b][m][n] = (f32x4){0.f, 0.f, 0.f, 0.f};
    f16x8 At[4][2], B0[2][2], B1[2][2]; i32x8 At8[4], B08[2], B18[2];
    const char* cA = (const char*)g.A + (size_t)cur.pm * tstep; const char* cB = (const char*)g.Bt + (size_t)cur.pn * tstep;
    if constexpr (Epi::SP2) {
        PG8_STAGE(PG8_SB(0, 0), cB, voffB); PG8_STAGE(PG8_SB(0, 1), cB + hstep, voffB); PG8_STAGE(PG8_SA(0, 0), cA, voffA); PG8_STAGE(PG8_SA(0, 1), cA + hstepA, voffA);
        if (wr == 1) PG8_BAR;
        PG8_WAIT_V(2); PG8_BAR;
        PG8_STAGE(PG8_SB(1, 0), cB + kstep, voffB); PG8_STAGE(PG8_SA(1, 0), cA + kstep, voffA); PG8_STAGE(PG8_SB(1, 1), cB + hstep + kstep, voffB);
        PG8_WAIT_V(6); PG8_BAR;
    } else {
        PG8_STAGE(PG8_SB(0, 0), cB, voffB); PG8_STAGE(PG8_SA(0, 0), cA, voffA); PG8_STAGE(PG8_SB(0, 1), cB + hstep, voffB); PG8_STAGE(PG8_SA(0, 1), cA + hstepA, voffA);
        if (wr == 1) PG8_BAR;
        PG8_WAIT_V(4); PG8_BAR;
        PG8_STAGE(PG8_SB(1, 0), cB + kstep, voffB); PG8_STAGE(PG8_SA(1, 0), cA + kstep, voffA); PG8_STAGE(PG8_SB(1, 1), cB + hstep + kstep, voffB);
        PG8_WAIT_V(6); PG8_BAR;
    }
    for (;;) {
        const bool has_next = S.next(ui + 1, nxt);
        const char* nA = has_next ? (const char*)g.A + (size_t)nxt.pm * tstep : cA; const char* nB = has_next ? (const char*)g.Bt + (size_t)nxt.pn * tstep : cB;
        for (int t = 0; t < nt; t += 2) {
            const bool last = (t == nt - 2);
            const char* a1 = cA + (size_t)(t + 1) * kstep;
            const char* a2 = last ? nA : cA + (size_t)(t + 2) * kstep; const char* b2 = last ? nB : cB + (size_t)(t + 2) * kstep;
            const char* a3 = a2 + kstep; const char* b3 = b2 + kstep;
            if constexpr (Epi::SP2) {
            PG8_LDB(B0, 0, 0); PG8_LDB(B1, 0, 1); PG8_SCHED; PG8_LDA(At, 0, 0); PG8_STAGE(PG8_SA(1, 1), a1 + hstepA, voffA);
            PG8_WAIT_V(8); PG8_WAIT_L(0); PG8_BAR; PG8_MMA(0, 0, At, B0); PG8_MMA(0, 1, At, B1); PG8_BAR; PG8_SCHED;
            PG8_LDA(At, 0, 1); PG8_STAGE(PG8_SB(0, 0), b2, voffB); PG8_STAGE(PG8_SB(0, 1), b2 + hstep, voffB); PG8_STAGE(PG8_SA(0, 0), a2, voffA);
            PG8_WAIT_V(8); PG8_WAIT_L(0); PG8_BAR; PG8_MMA(1, 0, At, B0); PG8_MMA(1, 1, At, B1); PG8_BAR; PG8_SCHED;
            PG8_LDB(B0, 1, 0); PG8_LDB(B1, 1, 1); PG8_SCHED; PG8_LDA(At, 1, 0); PG8_STAGE(PG8_SA(0, 1), a2 + hstepA, voffA);
            PG8_WAIT_V(8); PG8_WAIT_L(0); PG8_BAR; PG8_MMA(0, 0, At, B0); PG8_MMA(0, 1, At, B1); PG8_BAR; PG8_SCHED;
            PG8_LDA(At, 1, 1); PG8_STAGE(PG8_SB(1, 0), b3, voffB); PG8_STAGE(PG8_SB(1, 1), b3 + hstep, voffB); PG8_STAGE(PG8_SA(1, 0), a3, voffA);
            PG8_WAIT_V(8); PG8_WAIT_L(0); PG8_BAR; PG8_MMA(1, 0, At, B0); PG8_MMA(1, 1, At, B1); PG8_BAR; PG8_SCHED;
                    } else {
            PG8_LDB(B0, 0, 0); PG8_SCHED; PG8_LDA(At, 0, 0); PG8_STAGE(PG8_SA(1, 1), a1 + hstepA, voffA);
            PG8_WAIT_L(8); PG8_BAR; PG8_WAIT_L(0); PG8_MMA(0, 0, At, B0); PG8_BAR; PG8_SCHED;
            PG8_LDB(B1, 0, 1); PG8_STAGE(PG8_SB(0, 0), b2, voffB);
            PG8_BAR; PG8_WAIT_L(0); PG8_MMA(0, 1, At, B1); PG8_BAR;
            PG8_LDA(At, 0, 1); PG8_STAGE(PG8_SA(0, 0), a2, voffA);
            PG8_BAR; PG8_WAIT_L(0); PG8_MMA(1, 0, At, B0); PG8_BAR; PG8_SCHED;
            PG8_STAGE(PG8_SB(0, 1), b2 + hstep, voffB);
            PG8_WAIT_V(6); PG8_BAR; PG8_MMA(1, 1, At, B1); PG8_BAR;
            PG8_LDB(B0, 1, 0); PG8_SCHED; PG8_LDA(At, 1, 0); PG8_STAGE(PG8_SA(0, 1), a2 + hstepA, voffA);
            PG8_WAIT_L(8); PG8_BAR; PG8_WAIT_L(0); PG8_MMA(0, 0, At, B0); PG8_BAR; PG8_SCHED;
            PG8_LDB(B1, 1, 1); PG8_STAGE(PG8_SB(1, 0), b3, voffB);
            PG8_BAR; PG8_WAIT_L(0); PG8_MMA(0, 1, At, B1); PG8_BAR;
            PG8_LDA(At, 1, 1); PG8_STAGE(PG8_SA(1, 0), a3, voffA);
            PG8_BAR; PG8_WAIT_L(0); PG8_MMA(1, 0, At, B0); PG8_BAR; PG8_SCHED;
            PG8_STAGE(PG8_SB(1, 1), b3 + hstep, voffB);
            PG8_WAIT_V(6); PG8_BAR; PG8_MMA(1, 1, At, B1); PG8_BAR;
            }
        }
        if (wr == 0) PG8_BAR;
        if constexpr (Epi::MM == 2) asm volatile("s_nop 15\n\ts_nop 15" ::: "memory");
        E(acc, cur, wr, wc, fr, fq);
        if (!has_next) break;
#pragma unroll
        for (int a = 0; a < 2; ++a)
#pragma unroll
            for (int b = 0; b < 2; ++b)
#pragma unroll
                for (int m = 0; m < 4; ++m)
#pragma unroll
                    for (int n = 0; n < 2; ++n) acc[a][b][m][n] = (f32x4){0.f, 0.f, 0.f, 0.f};
        cur = nxt; cA = nA; cB = nB; ++ui;
        if (wr == 1) PG8_BAR;
    }
    PG8_WAIT_V(0);
    PG8_BAR;
#undef PG8_SA
#undef PG8_SB
#undef PG8_STAGE
#undef PG8_LDA
#undef PG8_LDB
#undef PG8_MMA
#undef PG8_WAIT_V
#undef PG8_WAIT_L
#undef PG8_BAR
#undef PG8_SCHED
}

struct EpiF32 {
    static constexpr bool PERM = false, ROWPERM = false, SP2 = true; static constexpr int MM = 1;
    float* C; int ldc;
    __device__ __forceinline__ void operator()(const f32x4 (&acc)[2][2][4][2], const Unit& u, int wr, int wc, int fr, int fq) const {
        const int row0 = u.pm * BM + wr * 64 + fr, col0 = u.pn * BM + wc * 32 + 4 * fq;
#pragma unroll
        for (int ai = 0; ai < 2; ++ai)
#pragma unroll
            for (int m = 0; m < 4; ++m) { float* rowp = C + (size_t)(row0 + ai * HALF + m * 16) * ldc + col0;
#pragma unroll
                for (int bj = 0; bj < 2; ++bj)
#pragma unroll
                    for (int n = 0; n < 2; ++n) *(f32x4*)(rowp + bj * HALF + n * 16) = acc[ai][bj][m][n]; }
    }
};
struct EpiB16 {
    static constexpr bool PERM = true, ROWPERM = false, SP2 = true; static constexpr int MM = 1;
    u16* C; int ldc;
    __device__ __forceinline__ void operator()(const f32x4 (&acc)[2][2][4][2], const Unit& u, int wr, int wc, int fr, int fq) const {
        const int row0 = u.pm * BM + wr * 64 + fr, col0 = u.pn * BM + wc * 32 + 8 * fq;
#pragma unroll
        for (int ai = 0; ai < 2; ++ai)
#pragma unroll
            for (int m = 0; m < 4; ++m) { u16* rowp = C + (size_t)(row0 + ai * HALF + m * 16) * ldc + col0;
#pragma unroll
                for (int bj = 0; bj < 2; ++bj) { const f32x4 v0 = acc[ai][bj][m][0], v1 = acc[ai][bj][m][1];
                    u32x4 w; w.x = pkb(v0.x, v0.y); w.y = pkb(v0.z, v0.w); w.z = pkb(v1.x, v1.y); w.w = pkb(v1.z, v1.w);
                    *(u32x4*)(rowp + bj * HALF) = w; } }
    }
};
struct EpiB16S8 {
    static constexpr bool PERM = true, ROWPERM = false, SP2 = true; static constexpr int MM = 2;
    u16* C; int ldc;
    __device__ __forceinline__ void operator()(const f32x4 (&acc)[2][2][4][2], const Unit& u, int wr, int wc, int fr, int fq) const {
        const int row0 = u.pm * BM + wr * 64 + fr, col0 = u.pn * BM + wc * 32 + 8 * fq; const float sc = 1.0f / 2048.0f;
#pragma unroll
        for (int ai = 0; ai < 2; ++ai)
#pragma unroll
            for (int m = 0; m < 4; ++m) { u16* rowp = C + (size_t)(row0 + ai * HALF + m * 16) * ldc + col0;
#pragma unroll
                for (int bj = 0; bj < 2; ++bj) { const f32x4 v0 = acc[ai][bj][m][0] * sc, v1 = acc[ai][bj][m][1] * sc;
                    u32x4 w; w.x = pkb(v0.x, v0.y); w.y = pkb(v0.z, v0.w); w.z = pkb(v1.x, v1.y); w.w = pkb(v1.z, v1.w);
                    *(u32x4*)(rowp + bj * HALF) = w; } }
    }
};
struct EpiB16F8 {
    static constexpr bool PERM = true, ROWPERM = false, SP2 = true; static constexpr int MM = 2;
    u16* C; int ldc;
    __device__ __forceinline__ void operator()(const f32x4 (&acc)[2][2][4][2], const Unit& u, int wr, int wc, int fr, int fq) const {
        const int row0 = u.pm * BM + wr * 64 + fr, col0 = u.pn * BM + wc * 32 + 8 * fq;
#pragma unroll
        for (int ai = 0; ai < 2; ++ai)
#pragma unroll
            for (int m = 0; m < 4; ++m) { u16* rowp = C + (size_t)(row0 + ai * HALF + m * 16) * ldc + col0;
#pragma unroll
                for (int bj = 0; bj < 2; ++bj) { const f32x4 v0 = acc[ai][bj][m][0], v1 = acc[ai][bj][m][1];
                    u32x4 w; w.x = pkb(v0.x, v0.y); w.y = pkb(v0.z, v0.w); w.z = pkb(v1.x, v1.y); w.w = pkb(v1.z, v1.w);
                    *(u32x4*)(rowp + bj * HALF) = w; } }
    }
};
struct EpiProj {
    static constexpr bool PERM = true, ROWPERM = false, SP2 = true; static constexpr int MM = 0;
    unsigned char* ws;
    __device__ __forceinline__ void operator()(const f32x4 (&acc)[2][2][4][2], const Unit& u, int wr, int wc, int fr, int fq) const {
        const int row0 = u.pm * BM + wr * 64 + fr; const int pn = u.pn;
        u16* base = (u16*)(ws + WS_QI); const int ldc = NIH * IDIM, colt = pn * 256;
        const int col0 = colt + wc * 32 + 8 * fq;
#pragma unroll
        for (int ai = 0; ai < 2; ++ai)
#pragma unroll
            for (int m = 0; m < 4; ++m) { u16* rowp = base + (size_t)(row0 + ai * HALF + m * 16) * ldc + col0;
#pragma unroll
                for (int bj = 0; bj < 2; ++bj) { const f32x4 v0 = acc[ai][bj][m][0], v1 = acc[ai][bj][m][1];
                    u32x4 w; w.x = pkh(v0[0], v0[1]); w.y = pkh(v0[2], v0[3]); w.z = pkh(v1[0], v1[1]); w.w = pkh(v1[2], v1[3]);
                    *(u32x4*)(rowp + bj * HALF) = w; } }
    }
};
__device__ __forceinline__ unsigned cvt2_fp8(float a, float b) { unsigned r; asm("v_cvt_pk_fp8_f32 %0, %1, %2" : "=v"(r) : "v"(a), "v"(b)); return r; }
struct EpiProjQ {
    static constexpr bool PERM = true, ROWPERM = false, SP2 = true; static constexpr int MM = 3;
    unsigned char* ws; const float* sa; const float* sb;
    __device__ __forceinline__ void operator()(const f32x4 (&acc)[2][2][4][2], const Unit& u, int wr, int wc, int fr, int fq) const {
        const int row0 = u.pm * BM + wr * 64 + fr; const int pn = u.pn;
        const float* sbp = sb + pn * 256 + wc * 32 + 8 * fq;
        const f32x4 sbv[2][2] = {{*(const f32x4*)(sbp), *(const f32x4*)(sbp + 4)}, {*(const f32x4*)(sbp + HALF), *(const f32x4*)(sbp + HALF + 4)}};
        float rsa[8];
#pragma unroll
        for (int q = 0; q < 8; ++q) rsa[q] = sa[row0 + (q >> 2) * HALF + (q & 3) * 16];
#define PRJ_V(ai_, bj_, m_, n_, rs_) ({ const i32x4 t_ = __builtin_bit_cast(i32x4, acc[ai_][bj_][m_][n_]); const int t0_ = t_.x, t1_ = t_.y, t2_ = t_.z, t3_ = t_.w; (f32x4){(float)t0_, (float)t1_, (float)t2_, (float)t3_} * sbv[bj_][n_] * (rs_); })
        if (pn < 16 || pn >= 28) {
            u16* base = (u16*)(ws + (pn < 8 ? WS_XL : pn < 16 ? WS_GATE : WS_QI)); const int col0 = (pn < 28 ? (pn & 7) : (pn - 28)) * 256 + wc * 32 + 8 * fq;
#pragma unroll
            for (int ai = 0; ai < 2; ++ai)
#pragma unroll
                for (int m = 0; m < 4; ++m) { const int row = row0 + ai * HALF + m * 16; u16* rowp = base + (size_t)row * DATT + col0; const float rs = rsa[4 * ai + m];
#pragma unroll
                    for (int bj = 0; bj < 2; ++bj) { const f32x4 v0 = PRJ_V(ai, bj, m, 0, rs), v1 = PRJ_V(ai, bj, m, 1, rs);
                        u32x4 w; w.x = pkh(v0[0], v0[1]); w.y = pkh(v0[2], v0[3]); w.z = pkh(v1[0], v1[1]); w.w = pkh(v1[2], v1[3]);
                        *(u32x4*)(rowp + bj * HALF) = w; } }
        } else {
            unsigned char* b8 = ws + (pn < 24 ? WS_Q : pn < 26 ? WS_K : WS_V); const int c8 = (pn < 24 ? (pn - 16) : (pn & 1)) * 256 + wc * 32 + 8 * fq; const int pitch = pn < 24 ? DATT : DKV;
#pragma unroll
            for (int ai = 0; ai < 2; ++ai)
#pragma unroll
                for (int m = 0; m < 4; ++m) { const int row = row0 + ai * HALF + m * 16; const float rs = 8.0f * rsa[4 * ai + m];
#pragma unroll
                    for (int bj = 0; bj < 2; ++bj) { const f32x4 v0 = PRJ_V(ai, bj, m, 0, rs), v1 = PRJ_V(ai, bj, m, 1, rs);
                        u32x2 w; w.x = (cvt2_fp8(sat8(v0.x), sat8(v0.y)) & 0xffffu) | (cvt2_fp8(sat8(v0.z), sat8(v0.w)) << 16); w.y = (cvt2_fp8(sat8(v1.x), sat8(v1.y)) & 0xffffu) | (cvt2_fp8(sat8(v1.z), sat8(v1.w)) << 16);
                        *(u32x2*)(b8 + (size_t)row * pitch + c8 + bj * HALF) = w; } }
        }
#undef PRJ_V
    }
};
__device__ __forceinline__ float dpp_shr1f(float x) { return __builtin_bit_cast(float, __builtin_amdgcn_update_dpp(0, __builtin_bit_cast(int, x), 0x111, 0xf, 0xf, false)); }
__device__ __forceinline__ f32x4 dpp_shr1(f32x4 v) {
    f32x4 r; r.x = dpp_shr1f(v.x); r.y = dpp_shr1f(v.y); r.z = dpp_shr1f(v.z); r.w = dpp_shr1f(v.w);
    return r;
}
struct EpiFfn {
    static constexpr bool PERM = true, ROWPERM = true, SP2 = true; static constexpr int MM = 3;
    u16* act; float* halo; const float* cw; const float* cb; const float* sa; const float* sb;
    __device__ __forceinline__ void operator()(const f32x4 (&acc)[2][2][4][2], const Unit& u, int wr, int wc, int fr, int fq) const {
        const int L = wr * 16 + fr, tok0 = u.pm * BM + 8 * L, run = 2 * u.pm + wr;
        const int f0 = u.pn * 128 + wc * 32 + 8 * fq;
        const f32x4 saL = *(const f32x4*)(sa + tok0), saH = *(const f32x4*)(sa + tok0 + 4);
        const float sap[8] = {saL.x, saL.y, saL.z, saL.w, saH.x, saH.y, saH.z, saH.w};
#define FFN_V(ai_, bj_, m_) ({ const i32x4 t_ = __builtin_bit_cast(i32x4, acc[ai_][bj_][m_][n]); const int t0_ = t_.x, t1_ = t_.y, t2_ = t_.z, t3_ = t_.w; (f32x4){(float)t0_, (float)t1_, (float)t2_, (float)t3_} * sap[4 * (ai_) + (m_)]; })
        u32x2 p0[8];
#pragma unroll
        for (int n = 0; n < 2; ++n) {
            const int fg = f0 + 4 * n, fu = DFF + fg;
            const f32x4 sg = *(const f32x4*)(sb + u.pn * 256 + wc * 32 + 8 * fq + 4 * n), su = *(const f32x4*)(sb + u.pn * 256 + 128 + wc * 32 + 8 * fq + 4 * n);
            const f32x4 g0 = *(const f32x4*)(cw + fg) * sg, g1 = *(const f32x4*)(cw + DFF2 + fg) * sg, g2 = *(const f32x4*)(cw + 2 * DFF2 + fg) * sg, gb = *(const f32x4*)(cb + fg);
            const f32x4 su2 = su * 2.0f; const f32x4 u0 = *(const f32x4*)(cw + fu) * su2, u1 = *(const f32x4*)(cw + DFF2 + fu) * su2, u2 = *(const f32x4*)(cw + 2 * DFF2 + fu) * su2, ub = *(const f32x4*)(cb + fu) * 2.0f;
            f32x4 gm2 = dpp_shr1(FFN_V(1, 0, 2)), gm1 = dpp_shr1(FFN_V(1, 0, 3)), um2 = dpp_shr1(FFN_V(1, 1, 2)), um1 = dpp_shr1(FFN_V(1, 1, 3));
            if (fr == 0) { float* hp = halo + (size_t)run * 4 * DFF2;
                *(f32x4*)(hp + fg) = FFN_V(0, 0, 0) * sg; *(f32x4*)(hp + DFF2 + fg) = FFN_V(0, 0, 1) * sg; *(f32x4*)(hp + fu) = FFN_V(0, 1, 0) * su; *(f32x4*)(hp + DFF2 + fu) = FFN_V(0, 1, 1) * su; }
            if (fr == 15) { float* hp = halo + ((size_t)run * 4 + 2) * DFF2;
                *(f32x4*)(hp + fg) = FFN_V(1, 0, 2) * sg; *(f32x4*)(hp + DFF2 + fg) = FFN_V(1, 0, 3) * sg; *(f32x4*)(hp + fu) = FFN_V(1, 1, 2) * su; *(f32x4*)(hp + DFF2 + fu) = FFN_V(1, 1, 3) * su; }
#pragma unroll
            for (int j = 0; j < 8; ++j) {
                const f32x4 pg = FFN_V(j >> 2, 0, j & 3), pu = FFN_V(j >> 2, 1, j & 3);
                const f32x4 ug = gb + g0 * gm2 + g1 * gm1 + g2 * pg, uu = ub + u0 * um2 + u1 * um1 + u2 * pu;
                gm2 = gm1; gm1 = pg; um2 = um1; um1 = pu;
                const f32x4 av = gelu_tanh4(ug) * uu; u32x2 pk; pk.x = cvt2_fp8(sat8(av.x), sat8(av.y)); pk.y = cvt2_fp8(sat8(av.z), sat8(av.w));
                if (n == 0) p0[j] = pk;
                else if (j >= 2 || fr != 0) { u32x2 w; w.x = (p0[j].x & 0xffffu) | (p0[j].y << 16); w.y = (pk.x & 0xffffu) | (pk.y << 16); *(u32x2*)((unsigned char*)act + (size_t)(tok0 + j) * DFF + f0) = w; }
            }
        }
#undef FFN_V
    }
};
}

#define XB_TMO      128
#define XB_XCNT(j)  (256  + 64 * (j))
#define XB_XSUB(j)  (1280 + 64 * (j))
#define XB_XGEN(j)  (2304 + 64 * (j))
#define XB_TOP      3328
#define XB_TOPGEN   3392
#define XCD_BAR_WORDS 3456
#define XB_SPIN_CAP (1u << 22)
__device__ __forceinline__ unsigned xb_ld(unsigned* p)              { return __hip_atomic_load(p, __ATOMIC_RELAXED, __HIP_MEMORY_SCOPE_AGENT); }
__device__ __forceinline__ unsigned xb_add(unsigned* p, unsigned v) { return __hip_atomic_fetch_add(p, v, __ATOMIC_RELAXED, __HIP_MEMORY_SCOPE_AGENT); }
__device__ __forceinline__ unsigned xb_xcc_id() { return (unsigned)__builtin_amdgcn_s_getreg((3 << 11) | 20) & 0xFu; }
#define XB_SPIN(cond, bar) do { unsigned _sp = 0; while (cond) { __builtin_amdgcn_s_sleep(1); \
    if ((++_sp & 255u) == 0u) { if (xb_ld(&(bar)[XB_TMO])) break; if (_sp > XB_SPIN_CAP) { atomicAdd(&(bar)[XB_TMO], 1u); break; } } } } while (0)
struct XcdBarrier { unsigned* bar; unsigned x; volatile LAS unsigned* st; };
__device__ __forceinline__ XcdBarrier xcd_barrier_post(unsigned* bar, volatile LAS unsigned* st) {
    XcdBarrier b; b.bar = bar; b.x = xb_xcc_id(); b.st = st;
    if (threadIdx.x == 0) (void)xb_add(&bar[XB_XCNT(b.x)], 1u);
    return b;
}
__device__ __forceinline__ void xcd_barrier_complete(unsigned* bar, unsigned x, unsigned& nloc, unsigned& nx) {
    const unsigned G = gridDim.x * gridDim.y * gridDim.z;
    unsigned sum, cnt, mine, sp = 0u;
    for (;;) {
        sum = 0u; cnt = 0u; mine = 0u;
#pragma unroll
        for (unsigned j = 0; j < 16; ++j) { const unsigned c = xb_ld(&bar[XB_XCNT(j)]); sum += c; cnt += (c > 0u) ? 1u : 0u; mine = (j == x) ? c : mine; }
        if (sum == G) break;
        __builtin_amdgcn_s_sleep(1);
        if ((++sp & 255u) == 0u) { if (xb_ld(&bar[XB_TMO])) break; if (sp > XB_SPIN_CAP) { atomicAdd(&bar[XB_TMO], 1u); break; } }
    }
    nloc = mine > 0u ? mine : 1u; nx = cnt > 0u ? cnt : 1u;
}
__device__ __forceinline__ void xcd_barrier(const XcdBarrier& b) {
    asm volatile("s_waitcnt vmcnt(0)" ::: "memory");
    __syncthreads();
    if (threadIdx.x == 0) {
        unsigned* bar = b.bar;
        __builtin_amdgcn_s_waitcnt(0);
        unsigned nloc = b.st[0], nx = b.st[1];
        if (nloc == 0u) { xcd_barrier_complete(bar, b.x, nloc, nx); b.st[0] = nloc; b.st[1] = nx; }
        const unsigned old = xb_add(&bar[XB_XSUB(b.x)], 1u);
        const unsigned gen = old / nloc;
        if (old + 1u == (gen + 1u) * nloc) {
            __builtin_amdgcn_fence(__ATOMIC_RELEASE, "agent");
            asm volatile("s_waitcnt vmcnt(0)" ::: "memory");
            const unsigned og = xb_add(&bar[XB_TOP], 1u);
            const unsigned tg = og / nx;
            if (og + 1u == (tg + 1u) * nx) xb_add(&bar[XB_TOPGEN], 1u);
            else XB_SPIN(xb_ld(&bar[XB_TOPGEN]) == tg, bar);
            __builtin_amdgcn_fence(__ATOMIC_ACQUIRE, "agent");
            xb_add(&bar[XB_XGEN(b.x)], 1u);
            asm volatile("s_waitcnt vmcnt(0)" ::: "memory");
        } else {
            XB_SPIN(xb_ld(&bar[XB_XGEN(b.x)]) == gen, bar);
            __builtin_amdgcn_fence(__ATOMIC_ACQUIRE, "agent");
            asm volatile("s_waitcnt vmcnt(0)" ::: "memory");
        }
    }
    __syncthreads();
}

struct Frame {
    LAS unsigned char* lds;
    unsigned char* ws;
    int tid, lane, wave, G, bid;
    const float* const __attribute__((address_space(4)))* kin; float* out;
    __device__ __forceinline__ const float* inp(int i) const { return kin[i]; }
};
enum { I_X = 0, I_C, I_WADA, I_BADA, I_GPREMIX, I_GPOSTMIX, I_GPREFFN, I_GPOSTFFN, I_WIN, I_CLW, I_CLB, I_WRA, I_BRA, I_WRX, I_BRX, I_LAM, I_GLRU, I_GATTN, I_WOUT, I_WFI, I_CFW, I_CFB, I_WFO };

template <int MODE> __device__ __forceinline__ void p0_transpose_item(const float* W, int K, int N, u16* WT, int dest_row0, LAS float* scr, int k0, int n0, int lane) {
#pragma unroll 8
    for (int i = 0; i < 32; ++i) { const int kk = 2 * i + (lane >> 5); scr[kk * 33 + (lane & 31)] = W[(size_t)(k0 + kk) * N + n0 + (lane & 31)]; }
    LDS_WAIT(); asm volatile("" ::: "memory");
    const int c = lane & 7;
#pragma unroll
    for (int j = 0; j < 4; ++j) { const int n = (lane >> 3) + 8 * j; const LAS float* s = scr + (8 * c) * 33 + n;
        if (MODE == 2) { int lo = __builtin_amdgcn_cvt_pk_fp8_f32(sat8(256.0f * s[0 * 33]), sat8(256.0f * s[1 * 33]), 0, false); lo = __builtin_amdgcn_cvt_pk_fp8_f32(sat8(256.0f * s[2 * 33]), sat8(256.0f * s[3 * 33]), lo, true);
            int hi = __builtin_amdgcn_cvt_pk_fp8_f32(sat8(256.0f * s[4 * 33]), sat8(256.0f * s[5 * 33]), 0, false); hi = __builtin_amdgcn_cvt_pk_fp8_f32(sat8(256.0f * s[6 * 33]), sat8(256.0f * s[7 * 33]), hi, true);
            u32x2 o8; o8.x = (unsigned)lo; o8.y = (unsigned)hi; *(u32x2*)((unsigned char*)WT + (size_t)(dest_row0 + n) * K + k0 + 8 * c) = o8; }
        else { u32x4 o; if (MODE == 1) { o.x = pkb(s[0 * 33], s[1 * 33]); o.y = pkb(s[2 * 33], s[3 * 33]); o.z = pkb(s[4 * 33], s[5 * 33]); o.w = pkb(s[6 * 33], s[7 * 33]); }
            else { o.x = pkh(s[0 * 33], s[1 * 33]); o.y = pkh(s[2 * 33], s[3 * 33]); o.z = pkh(s[4 * 33], s[5 * 33]); o.w = pkh(s[6 * 33], s[7 * 33]); }
            *(u32x4*)(WT + (size_t)(dest_row0 + n) * K + k0 + 8 * c) = o; } }
    LDS_WAIT(); asm volatile("" ::: "memory");
}
__device__ __forceinline__ void p0_phase(Frame& F) {
    {
        LAS float* scl = (LAS float*)F.lds;
        LAS float* red = (LAS float*)(F.lds + 65536);
        const float* c = F.inp(I_C);
        for (int i = F.tid; i < BATCH * DM; i += NTHR) { const float v = c[i]; scl[i] = v / (1.0f + expf(-v)); }
        __syncthreads();
        float* mod = (float*)(F.ws + WS_MOD);
        const int cq = F.tid % 24, kl = F.tid / 24;
        for (int cb = F.bid; cb < NMOD / 96; cb += F.G) {
            if (kl < 16) {
                const float* wp = F.inp(I_WADA) + (size_t)kl * NMOD + 96 * cb + 4 * cq;
                f32x4 a0 = {0, 0, 0, 0}, a1 = a0, a2 = a0, a3 = a0;
#pragma unroll 8
                for (int i = 0; i < DM / 16; ++i) {
                    const f32x4 w = *(const f32x4*)(wp + (size_t)i * 16 * NMOD); const int k = kl + 16 * i;
                    a0 += w * scl[k]; a1 += w * scl[DM + k]; a2 += w * scl[2 * DM + k]; a3 += w * scl[3 * DM + k];
                }
                *(LAS f32x4*)(red + (kl * 4 + 0) * 96 + 4 * cq) = a0; *(LAS f32x4*)(red + (kl * 4 + 1) * 96 + 4 * cq) = a1;
                *(LAS f32x4*)(red + (kl * 4 + 2) * 96 + 4 * cq) = a2; *(LAS f32x4*)(red + (kl * 4 + 3) * 96 + 4 * cq) = a3;
            }
            __syncthreads();
            if (F.tid < 384) { const int b = F.tid / 96, col = F.tid % 96; float s = 0.f;
#pragma unroll
                for (int k = 0; k < 16; ++k) s += red[(k * 4 + b) * 96 + col];
                mod[b * NMOD + 96 * cb + col] = s + F.inp(I_BADA)[96 * cb + col]; }
            __syncthreads();
        }
    }
    {
        LAS float* scr = (LAS float*)(F.lds + F.wave * 16384);
        const int gw = F.bid * NWAVES + F.wave, NGW = F.G * NWAVES;
        constexpr int I_1 = (DM / 64) * (DIN / 32);
        for (int it = gw; it < I_1; it += NGW) { const int nblk = DIN / 32, kb = it / nblk, nb = it % nblk;
            if (nb >= 288) p0_transpose_item<0>(F.inp(I_WIN), DM, DIN, (u16*)(F.ws + WS_WIN), 32 * (nb - 288), scr, 64 * kb, 32 * nb, F.lane); }
        { u16* WT = (u16*)(F.ws + WS_WRG);
          for (int e = F.bid * NTHR + F.tid; e < NLB * 256 * LB; e += F.G * NTHR) { const int i = e & 127, o = (e >> 7) & 255, nb = e >> 15;
              const float* W = (o < 128) ? F.inp(I_WRA) : F.inp(I_WRX);
              WT[e] = __builtin_bit_cast(u16, (f16)W[((size_t)nb * LB + i) * LB + (o & 127)]); } }
    }
}

__device__ __forceinline__ void p1_phase(Frame& F) {
    const float* mod = (const float*)(F.ws + WS_MOD); u16* H = (u16*)(F.ws + WS_H);
    LAS f32x4* va = (LAS f32x4*)F.lds; LAS f32x4* vb = va + DM / 4;
    for (int blk = F.bid; blk < M / 64; blk += F.G) {
        const int b = (blk * 64) / SEQ;
        __syncthreads();
        for (int i = F.tid; i < DM / 4; i += NTHR) { va[i] = ((const f32x4*)F.inp(I_GPREMIX))[i] * (1.0f + ((const f32x4*)(mod + b * NMOD + DM))[i]); vb[i] = ((const f32x4*)(mod + b * NMOD))[i]; }
        __syncthreads();
        const int row0 = blk * 64 + F.wave * 8;
        f32x4 nx[16];
#pragma unroll
        for (int j = 0; j < 16; ++j) nx[j] = ((const f32x4*)(F.inp(I_X) + (size_t)row0 * DM) + F.lane)[64 * j];
#pragma unroll 1
        for (int ri = 0; ri < 8; ++ri) {
            const int row = row0 + ri;
            f32x4 v[16]; float s = 0.f;
#pragma unroll
            for (int j = 0; j < 16; ++j) { v[j] = nx[j]; s += (v[j].x * v[j].x + v[j].y * v[j].y) + (v[j].z * v[j].z + v[j].w * v[j].w); }
            if (ri < 7) {
#pragma unroll
                for (int j = 0; j < 16; ++j) nx[j] = ((const f32x4*)(F.inp(I_X) + (size_t)(row + 1) * DM) + F.lane)[64 * j]; }
            const float rstd = 1.0f / sqrtf(wave_sum(s) * (1.0f / DM) + RMS_EPS);
            u32x2* o = (u32x2*)(H + (size_t)row * DM) + F.lane; unsigned* o8 = (unsigned*)(F.ws + WS_H8 + (size_t)row * DM) + F.lane;
            float am = 0.f;
#pragma unroll
            for (int j = 0; j < 16; ++j) { const f32x4 y = v[j] * rstd * va[F.lane + 64 * j] + vb[F.lane + 64 * j]; u32x2 w; w.x = pkh(y.x, y.y); w.y = pkh(y.z, y.w); o[64 * j] = w;
                am = fmaxf(fmaxf(am, fmaxf(fabsf(y.x), fabsf(y.y))), fmaxf(fabsf(y.z), fabsf(y.w))); }
#pragma unroll
            for (int off = 32; off >= 1; off >>= 1) am = fmaxf(am, __shfl_xor(am, off));
            const float qs = am > 0.f ? am * (1.0f / 127.0f) : 1.0f, qi = 1.0f / qs;
            if (F.lane == 0) ((float*)(F.ws + WS_SA_H1))[row] = qs;
#pragma unroll
            for (int j = 0; j < 16; ++j) { if ((j & 3) == 0) __builtin_amdgcn_sched_barrier(0);
                const f32x4 y = (v[j] * rstd * va[F.lane + 64 * j] + vb[F.lane + 64 * j]) * qi;
                const int q0 = __float2int_rn(y.x), q1 = __float2int_rn(y.y), q2 = __float2int_rn(y.z), q3 = __float2int_rn(y.w);
                o8[64 * j] = (unsigned)(q0 & 255) | ((unsigned)(q1 & 255) << 8) | ((unsigned)(q2 & 255) << 16) | ((unsigned)q3 << 24); }
        }
    }
}

template <int MODE> __device__ __forceinline__ void lc_transpose_item(const float* W, int K, int N, u16* WT, int dest_row0, LAS float* scr, int k0, int n0, int lane) {
    float t[32];
    const float* wp = W + (size_t)(k0 + (lane >> 5)) * N + n0 + (lane & 31);
#pragma unroll
    for (int i = 0; i < 32; ++i) t[i] = wp[(size_t)(2 * i) * N];
#pragma unroll
    for (int i = 0; i < 32; ++i) scr[(2 * i + (lane >> 5)) * 33 + (lane & 31)] = t[i];
    LDS_WAIT(); asm volatile("" ::: "memory");
    const int c = lane & 7;
#pragma unroll
    for (int j = 0; j < 4; ++j) { const int n = (lane >> 3) + 8 * j; const LAS float* s = scr + (8 * c) * 33 + n;
        if (MODE == 2) { int lo = __builtin_amdgcn_cvt_pk_fp8_f32(sat8(256.0f * s[0 * 33]), sat8(256.0f * s[1 * 33]), 0, false); lo = __builtin_amdgcn_cvt_pk_fp8_f32(sat8(256.0f * s[2 * 33]), sat8(256.0f * s[3 * 33]), lo, true);
            int hi = __builtin_amdgcn_cvt_pk_fp8_f32(sat8(256.0f * s[4 * 33]), sat8(256.0f * s[5 * 33]), 0, false); hi = __builtin_amdgcn_cvt_pk_fp8_f32(sat8(256.0f * s[6 * 33]), sat8(256.0f * s[7 * 33]), hi, true);
            u32x2 o8; o8.x = (unsigned)lo; o8.y = (unsigned)hi; *(u32x2*)((unsigned char*)WT + (size_t)(dest_row0 + n) * K + k0 + 8 * c) = o8; }
        else { u32x4 o; o.x = pkb(s[0 * 33], s[1 * 33]); o.y = pkb(s[2 * 33], s[3 * 33]); o.z = pkb(s[4 * 33], s[5 * 33]); o.w = pkb(s[6 * 33], s[7 * 33]);
            *(u32x4*)(WT + (size_t)(dest_row0 + n) * K + k0 + 8 * c) = o; } }
    LDS_WAIT(); asm volatile("" ::: "memory");
}
template <int Q> __device__ __forceinline__ void late_convert(Frame& F) {
    LAS float* scr = (LAS float*)(F.lds + F.wave * 16384);
    unsigned* q = (unsigned*)(F.ws + WS_CTL) + (Q == 0 ? CW_CONVQ : CW_CONVQ2);
    constexpr int I_2 = (DM / 64) * (DM / 32), I_4 = (DFF / 64) * (DM / 32), NL = Q == 0 ? I_2 : I_4, CH = 8, KD = Q == 0 ? DM : DFF;
    const float* W = Q == 0 ? F.inp(I_WOUT) : F.inp(I_WFO); unsigned char* WT = F.ws + (Q == 0 ? WS_WOUT : WS_WFO);
    const int lane = F.lane, c = lane & 7;
#define LC_LOAD(t_, r_) do { const int kb_ = (r_) / (DM / 32), nb_ = (r_) % (DM / 32); const float* wp_ = W + (size_t)(64 * kb_ + (lane >> 5)) * DM + 32 * nb_ + (lane & 31); \
        _Pragma("unroll") for (int i = 0; i < 32; ++i) t_[i] = wp_[(size_t)(2 * i) * DM]; } while (0)
#define LC_STORE(t_, r_) do { const int kb_ = (r_) / (DM / 32), nb_ = (r_) % (DM / 32); \
        _Pragma("unroll") for (int i = 0; i < 32; ++i) scr[(2 * i + (lane >> 5)) * 33 + (lane & 31)] = t_[i]; \
        LDS_WAIT(); asm volatile("" ::: "memory"); \
        _Pragma("unroll") for (int j = 0; j < 4; ++j) { const int n = (lane >> 3) + 8 * j; const LAS float* s_ = scr + (8 * c) * 33 + n; \
            int lo = __builtin_amdgcn_cvt_pk_fp8_f32(sat8(256.0f * s_[0 * 33]), sat8(256.0f * s_[1 * 33]), 0, false); lo = __builtin_amdgcn_cvt_pk_fp8_f32(sat8(256.0f * s_[2 * 33]), sat8(256.0f * s_[3 * 33]), lo, true); \
            int hi = __builtin_amdgcn_cvt_pk_fp8_f32(sat8(256.0f * s_[4 * 33]), sat8(256.0f * s_[5 * 33]), 0, false); hi = __builtin_amdgcn_cvt_pk_fp8_f32(sat8(256.0f * s_[6 * 33]), sat8(256.0f * s_[7 * 33]), hi, true); \
            u32x2 o8; o8.x = (unsigned)lo; o8.y = (unsigned)hi; *(u32x2*)(WT + (size_t)(32 * nb_ + n) * KD + 64 * kb_ + 8 * c) = o8; } \
        LDS_WAIT(); asm volatile("" ::: "memory"); } while (0)
    int nxt = 0; if (lane == 0) nxt = (int)__hip_atomic_fetch_add(q, (unsigned)CH, __ATOMIC_RELAXED, __HIP_MEMORY_SCOPE_AGENT);
    nxt = __builtin_amdgcn_readfirstlane(nxt);
    while (nxt < NL) {
        const int cur = nxt;
        if (lane == 0) nxt = (int)__hip_atomic_fetch_add(q, (unsigned)CH, __ATOMIC_RELAXED, __HIP_MEMORY_SCOPE_AGENT);
        float ta[32], tb[32];
        LC_LOAD(ta, cur);
#pragma unroll
        for (int e = 0; e < CH; e += 2) {
            LC_LOAD(tb, cur + e + 1);
            LC_STORE(ta, cur + e);
            if (e + 2 < CH) LC_LOAD(ta, cur + e + 2);
            LC_STORE(tb, cur + e + 1);
        }
        nxt = __builtin_amdgcn_readfirstlane(nxt);
    }
#undef LC_LOAD
#undef LC_STORE
}

__device__ __forceinline__ void wq_absmax_item(const float* W, int N, int k0, int n0, unsigned* mx, int lane) {
    const float* wp = W + (size_t)(k0 + (lane >> 5)) * N + n0 + (lane & 31);
    float t[32];
#pragma unroll
    for (int i = 0; i < 32; ++i) t[i] = wp[(size_t)(2 * i) * N];
    float m = 0.f;
#pragma unroll
    for (int i = 0; i < 32; ++i) m = fmaxf(m, fabsf(t[i]));
    m = fmaxf(m, __shfl_xor(m, 32));
    if (lane < 32) atomicMax(mx + lane, __float_as_uint(m));
}
__device__ __forceinline__ void wq_quant_item(const float* W, int K, int N, unsigned char* WT, int drow, LAS float* scr, int k0, int n0, const unsigned* mx, float* SB, int lane) {
    float t[32];
    const float* wp = W + (size_t)(k0 + (lane >> 5)) * N + n0 + (lane & 31);
#pragma unroll
    for (int i = 0; i < 32; ++i) t[i] = wp[(size_t)(2 * i) * N];
#pragma unroll
    for (int i = 0; i < 32; ++i) scr[(2 * i + (lane >> 5)) * 33 + (lane & 31)] = t[i];
    LDS_WAIT(); asm volatile("" ::: "memory");
    const int c = lane & 7;
#pragma unroll
    for (int j = 0; j < 4; ++j) { const int n = (lane >> 3) + 8 * j; const LAS float* sp = scr + (8 * c) * 33 + n;
        const float am = __uint_as_float(mx[n]); const float qs = am > 0.f ? am * (1.0f / 127.0f) : 1.0f, qi = 1.0f / qs;
        if (k0 == 0 && c == 0) SB[drow + n] = qs;
        int q[8];
#pragma unroll
        for (int e = 0; e < 8; ++e) q[e] = __float2int_rn(sp[e * 33] * qi);
        u32x2 o8; o8.x = (unsigned)(q[0] & 255) | ((unsigned)(q[1] & 255) << 8) | ((unsigned)(q[2] & 255) << 16) | ((unsigned)q[3] << 24);
        o8.y = (unsigned)(q[4] & 255) | ((unsigned)(q[5] & 255) << 8) | ((unsigned)(q[6] & 255) << 16) | ((unsigned)q[7] << 24);
        *(u32x2*)(WT + (size_t)(drow + n) * K + k0 + 8 * c) = o8; }
    LDS_WAIT(); asm volatile("" ::: "memory");
}
__device__ __forceinline__ int wfi_drow(int n0) { const int up = n0 >= DFF ? 1 : 0, f = n0 - up * DFF; return (f >> 7) * 256 + up * 128 + (f & 127); }
__device__ __forceinline__ void wq_sweep1(Frame& F) {
    unsigned* ctl = (unsigned*)(F.ws + WS_CTL);
    const int gw = F.bid * NWAVES + F.wave, NGW = F.G * NWAVES;
    constexpr int I_3 = (DM / 64) * (DFF2 / 32);
    for (int it = gw; it < I_3; it += NGW) { const int nblk = DFF2 / 32, kb = it / nblk, nb = it % nblk;
        wq_absmax_item(F.inp(I_WFI), DFF2, 64 * kb, 32 * nb, ctl + CW_WMAX_WFI + wfi_drow(32 * nb), F.lane); }
    constexpr int I_1 = (DM / 64) * 288;
    for (int it = gw; it < I_1; it += NGW) { const int kb = it / 288, nb = it % 288;
        wq_absmax_item(F.inp(I_WIN), DIN, 64 * kb, 32 * nb, ctl + CW_WMAX_WIN + 32 * nb, F.lane); }
}
__device__ __forceinline__ void wq_sweep2(Frame& F) {
    const unsigned* ctl = (const unsigned*)(F.ws + WS_CTL);
    LAS float* scr = (LAS float*)(F.lds + F.wave * 16384);
    const int gw = F.bid * NWAVES + F.wave, NGW = F.G * NWAVES;
    constexpr int I_3 = (DM / 64) * (DFF2 / 32);
    for (int it = gw; it < I_3; it += NGW) { const int nblk = DFF2 / 32, kb = it / nblk, nb = it % nblk; const int drow = wfi_drow(32 * nb);
        wq_quant_item(F.inp(I_WFI), DM, DFF2, F.ws + WS_WFI, drow, scr, 64 * kb, 32 * nb, ctl + CW_WMAX_WFI + drow, (float*)(F.ws + WS_SB_WFI), F.lane); }
}
__device__ __forceinline__ void wq_sweep2_win(Frame& F) {
    const unsigned* ctl = (const unsigned*)(F.ws + WS_CTL);
    LAS float* scr = (LAS float*)(F.lds + F.wave * 16384);
    const int gw = F.bid * NWAVES + F.wave, NGW = F.G * NWAVES;
    constexpr int I_1 = (DM / 64) * 288;
    for (int it = gw; it < I_1; it += NGW) { const int kb = it / 288, nb = it % 288;
        wq_quant_item(F.inp(I_WIN), DM, DIN, F.ws + WS_WIN8, 32 * nb, scr, 64 * kb, 32 * nb, ctl + CW_WMAX_WIN + 32 * nb, (float*)(F.ws + WS_SB_WIN), F.lane); }
}

__device__ __forceinline__ void wq_onepass(Frame& F) {
    LAS unsigned char* T = F.lds;
    constexpr int TPB = 8720, NLG1 = 288, NLG = 288 + 688;
    const int t = F.tid, lane = F.lane;
    const bool affine = (F.G % 16) == 0;
    const int slots = affine ? (F.G >> 1) : 0, slot = affine ? ((F.bid >> 4) * 8 + (F.bid & 7)) : 0, sib = affine ? ((F.bid >> 3) & 1) : 0;
    int cb = affine ? (slot < NLG ? 2 * slot + sib : 2 * NLG) : F.bid; const int cstep = affine ? 2 * slots : F.G;
    f32x4 v[32];
#define WQ_SRC(cb_, Wp_, Np_, c0_) const int lg_ = (cb_) >> 1; const bool w1_ = lg_ < NLG1; const float* Wp_ = w1_ ? F.inp(I_WIN) : F.inp(I_WFI); const int Np_ = w1_ ? DIN : DFF2; const int c0_ = (w1_ ? 32 * lg_ : 32 * (lg_ - NLG1)) + 16 * ((cb_) & 1);
#define WQ_LOAD(cb_) do { WQ_SRC(cb_, Wl_, Nl_, cl_) const float* wl_ = Wl_ + (size_t)(2 * (t >> 2)) * Nl_ + cl_ + 4 * (t & 3); \
        _Pragma("unroll") for (int i = 0; i < 32; ++i) v[i] = *(const f32x4*)(wl_ + (size_t)(256 * (i >> 1) + (i & 1)) * Nl_); } while (0)
    if (cb < 2 * NLG) WQ_LOAD(cb);
    for (; cb < 2 * NLG; cb += cstep) {
        __syncthreads();
#pragma unroll
        for (int j = 0; j < 16; ++j) { const int k = 2 * ((t >> 2) + 128 * j); LAS unsigned char* p = T + (4 * (t & 3)) * TPB + 2 * k + 16 * (k >> 7);
            *(LAS unsigned*)(p) = pkb(v[2 * j].x, v[2 * j + 1].x); *(LAS unsigned*)(p + TPB) = pkb(v[2 * j].y, v[2 * j + 1].y);
            *(LAS unsigned*)(p + 2 * TPB) = pkb(v[2 * j].z, v[2 * j + 1].z); *(LAS unsigned*)(p + 3 * TPB) = pkb(v[2 * j].w, v[2 * j + 1].w); }
        __syncthreads();
        if (cb + cstep < 2 * NLG) WQ_LOAD(cb + cstep);
        WQ_SRC(cb, Wc, Nc, c0)
        (void)Wc; (void)Nc;
        unsigned char* WT = F.ws + (w1_ ? WS_WIN8 : WS_WFI); float* SB = (float*)(F.ws + (w1_ ? WS_SB_WIN : WS_SB_WFI));
#pragma unroll
        for (int cc = 0; cc < 2; ++cc) {
            const int n = 2 * F.wave + cc;
            const int drow = (w1_ ? c0 : wfi_drow(32 * (lg_ - NLG1)) + 16 * (cb & 1)) + n;
            const LAS unsigned char* col = T + n * TPB;
            float m = 0.f;
#pragma unroll
            for (int i = 0; i < 8; ++i) { const int k = 8 * (lane + 64 * i); const u32x4 x = *(const LAS u32x4*)(col + 2 * k + 16 * (k >> 7));
                const unsigned xa[4] = {x.x, x.y, x.z, x.w};
#pragma unroll
                for (int e = 0; e < 4; ++e) m = fmaxf(m, fmaxf(fabsf(__builtin_bit_cast(float, xa[e] << 16)), fabsf(__builtin_bit_cast(float, xa[e] & 0xffff0000u)))); }
#pragma unroll
            for (int off = 32; off >= 1; off >>= 1) m = fmaxf(m, __shfl_xor(m, off));
            const float qs = m > 0.f ? m * (1.0f / 127.0f) : 1.0f, qi = 1.0f / qs;
            if (lane == 0) SB[drow] = qs;
#pragma unroll
            for (int jj = 0; jj < 4; ++jj) { const int c = lane + 64 * jj; const LAS unsigned char* cp = col + 32 * c + 16 * (c >> 3);
                const u32x4 x0 = *(const LAS u32x4*)(cp), x1 = *(const LAS u32x4*)(cp + 16);
                const unsigned xa[8] = {x0.x, x0.y, x0.z, x0.w, x1.x, x1.y, x1.z, x1.w}; unsigned o[4];
#pragma unroll
                for (int e = 0; e < 4; ++e) {
                    const int q0 = __float2int_rn(__builtin_bit_cast(float, xa[2 * e] << 16) * qi), q1 = __float2int_rn(__builtin_bit_cast(float, xa[2 * e] & 0xffff0000u) * qi);
                    const int q2 = __float2int_rn(__builtin_bit_cast(float, xa[2 * e + 1] << 16) * qi), q3 = __float2int_rn(__builtin_bit_cast(float, xa[2 * e + 1] & 0xffff0000u) * qi);
                    o[e] = (unsigned)(q0 & 255) | ((unsigned)(q1 & 255) << 8) | ((unsigned)(q2 & 255) << 16) | ((unsigned)q3 << 24); }
                u32x4 ov; ov.x = o[0]; ov.y = o[1]; ov.z = o[2]; ov.w = o[3];
                *(u32x4*)(WT + (size_t)drow * DM + 16 * c) = ov; }
        }
    }
#undef WQ_LOAD
#undef WQ_SRC
}

__device__ __forceinline__ void p2b_thin(Frame& F) {
    const u16* H = (const u16*)(F.ws + WS_H); const u16* W = (const u16*)(F.ws + WS_WIN) + (size_t)WIN_KI_ROW * DM;
    u16* KI = (u16*)(F.ws + WS_KI); float* WI = (float*)(F.ws + WS_WI);
    const int kq = F.wave & 3, rh = F.wave >> 2, fr = F.lane & 15, fq = F.lane >> 4;
    LAS float* part = (LAS float*)F.lds;
    for (int u = F.bid; u < M / 64; u += F.G) {
        const u16* ap = H + (size_t)(64 * u + 32 * rh + fr) * DM + 1024 * kq + 8 * fq;
        const u16* bp = W + (size_t)fr * DM + 1024 * kq + 8 * fq;
        f32x4 acc[2][6];
#pragma unroll
        for (int m = 0; m < 2; ++m)
#pragma unroll
            for (int n = 0; n < 6; ++n) acc[m][n] = (f32x4){0.f, 0.f, 0.f, 0.f};
        f16x8 a0[2][2], b0[6][2], a1[2][2], b1[6][2];
#define P2B_LOAD(a, b, s) do { _Pragma("unroll") for (int m = 0; m < 2; ++m) _Pragma("unroll") for (int h = 0; h < 2; ++h) a[m][h] = *(const f16x8*)(ap + (size_t)(16 * m) * DM + 64 * (s) + 32 * h); \
        _Pragma("unroll") for (int n = 0; n < 6; ++n) _Pragma("unroll") for (int h = 0; h < 2; ++h) b[n][h] = *(const f16x8*)(bp + (size_t)(16 * n) * DM + 64 * (s) + 32 * h); } while (0)
#define P2B_MMA(a, b) do { _Pragma("unroll") for (int m = 0; m < 2; ++m) _Pragma("unroll") for (int n = 0; n < 6; ++n) _Pragma("unroll") for (int h = 0; h < 2; ++h) \
        acc[m][n] = __builtin_amdgcn_mfma_f32_16x16x32_f16(b[n][h], a[m][h], acc[m][n], 0, 0, 0); } while (0)
        P2B_LOAD(a0, b0, 0);
#pragma unroll 1
        for (int s = 0; s < 16; s += 2) {
            P2B_LOAD(a1, b1, s + 1);
            P2B_MMA(a0, b0);
            if (s + 2 < 16) P2B_LOAD(a0, b0, s + 2);
            P2B_MMA(a1, b1);
        }
#undef P2B_LOAD
#undef P2B_MMA
#pragma unroll
        for (int m = 0; m < 2; ++m)
#pragma unroll
            for (int n = 0; n < 6; ++n) *(LAS f32x4*)(part + (kq * 64 + 32 * rh + 16 * m + fr) * 100 + 16 * n + 4 * fq) = acc[m][n];
        __syncthreads();
        { const int r = 8 * F.wave + (F.lane >> 3), c8 = F.lane & 7;
          f32x4 s0 = {0.f, 0.f, 0.f, 0.f}, s1 = s0, s2 = s0;
#pragma unroll
          for (int q = 0; q < 4; ++q) { const LAS float* p = part + (q * 64 + r) * 100; s0 += *(const LAS f32x4*)(p + 8 * c8); s1 += *(const LAS f32x4*)(p + 8 * c8 + 4); s2 += *(const LAS f32x4*)(p + 64 + 4 * c8); }
          u32x4 w; w.x = pkh(s0[0], s0[1]); w.y = pkh(s0[2], s0[3]); w.z = pkh(s1[0], s1[1]); w.w = pkh(s1[2], s1[3]);
          *(u32x4*)(KI + (size_t)(64 * u + r) * IDIM + 8 * c8) = w;
          *(f32x4*)(WI + (size_t)(64 * u + r) * NIH + 4 * c8) = s2; }
        __syncthreads();
    }
}

__device__ __forceinline__ void p3_phase(Frame& F) {
    LAS float* xc = (LAS float*)F.lds; LAS float* as = xc + 64 * 128; LAS float* us = as + 64 * 128;
    const u16* XL = (const u16*)(F.ws + WS_XL); const u16* GT = (const u16*)(F.ws + WS_GATE); float* YL = (float*)(F.ws + WS_YL);
    const float* cw = F.inp(I_CLW); const float* cbias = F.inp(I_CLB);
    for (int unit = F.bid; unit < BATCH * NLB; unit += F.G) {
        const int b = unit / NLB, nb = unit % NLB;
        const int jj = F.tid & 127, tg = F.tid >> 7, dj = nb * LB + jj;
        const float lam = F.inp(I_LAM)[dj];
        const float cdec = -8.0f * log1pf(expf(-lam));
        const float ba = F.inp(I_BRA)[dj], bx = F.inp(I_BRX)[dj];
        const float* wa = F.inp(I_WRA) + (size_t)nb * LB * LB + jj; const float* wx = F.inp(I_WRX) + (size_t)nb * LB * LB + jj;
        float hstate = 0.f;
        for (int tile = 0; tile < SEQ / 64; ++tile) {
            const int t0 = tile * 64;
            for (int e = F.tid; e < 64 * 128; e += NTHR) { const int tt = e >> 7, ch = e & 127, t = t0 + tt, d = nb * LB + ch; float v = cbias[d];
#pragma unroll
                for (int j = 0; j < 4; ++j) { const int ts = t - 3 + j; if (ts >= 0) v += cw[j * DLRU + d] * h2f(XL[(size_t)(b * SEQ + ts) * DLRU + d]); }
                xc[e] = v; }
            __syncthreads();
            float accr[16], acci[16];
#pragma unroll
            for (int tt = 0; tt < 16; ++tt) { accr[tt] = 0.f; acci[tt] = 0.f; }
            for (int i4 = 0; i4 < 32; ++i4) {
                float wav[4], wxv[4];
#pragma unroll
                for (int e = 0; e < 4; ++e) { wav[e] = wa[(size_t)(4 * i4 + e) * LB]; wxv[e] = wx[(size_t)(4 * i4 + e) * LB]; }
#pragma unroll
                for (int tt = 0; tt < 16; ++tt) { const f32x4 xv = *(const LAS f32x4*)(xc + (tg * 16 + tt) * 128 + 4 * i4);
                    accr[tt] += xv.x * wav[0] + xv.y * wav[1] + xv.z * wav[2] + xv.w * wav[3];
                    acci[tt] += xv.x * wxv[0] + xv.y * wxv[1] + xv.z * wxv[2] + xv.w * wxv[3]; }
            }
#pragma unroll
            for (int tt = 0; tt < 16; ++tt) { const int tl = tg * 16 + tt;
                const float r = sigmoidf_(accr[tt] + ba), ig = sigmoidf_(acci[tt] + bx);
                const float la = cdec * r; const float a = expf(la); const float mult = sqrtf(-expm1f(2.0f * la));
                as[tl * 128 + jj] = a; us[tl * 128 + jj] = mult * ig * xc[tl * 128 + jj]; }
            __syncthreads();
            if (F.tid < 128) {
                for (int tt = 0; tt < 64; ++tt) { hstate = as[tt * 128 + F.tid] * hstate + us[tt * 128 + F.tid];
                    const size_t o = (size_t)(b * SEQ + t0 + tt) * DLRU + dj;
                    YL[o] = hstate * gelu_tanh(h2f(GT[o])); }
            }
            __syncthreads();
        }
    }
}

struct Frame;
__device__ __forceinline__ void chk_flag(Frame& F, int bit, bool bad);
__device__ __forceinline__ float shfl_up16(float v) { return __shfl_up(v, 16); }
__device__ __forceinline__ void p3_fast(Frame& F) {
    LAS unsigned char* xc16 = F.lds;
    LAS float* xc32 = (LAS float*)(F.lds + 17408);
    LAS u16* gt16 = (LAS u16*)(F.lds + 17408 + 32768);
    const u16* XL = (const u16*)(F.ws + WS_XL); const u16* GT = (const u16*)(F.ws + WS_GATE); float* YL = (float*)(F.ws + WS_YL);
    const u16* WT = (const u16*)(F.ws + WS_WRG);
    const int lane = F.lane, cl = lane & 15, lg = lane >> 4;
    const int chunk8 = F.tid & 15, trow = F.tid >> 4;
    for (int unit = F.bid; unit < BATCH * NLB; unit += F.G) {
        const int b = unit / NLB, nb = unit % NLB;
        const int c = 16 * F.wave + cl, d = nb * LB + c;
        const float lam = F.inp(I_LAM)[d], cdec = -8.0f * log1pf(expf(-lam)), ba = F.inp(I_BRA)[d], bx = F.inp(I_BRX)[d];
        f16x8 Bfr[2][4];
#pragma unroll
        for (int wh = 0; wh < 2; ++wh)
#pragma unroll
            for (int ks = 0; ks < 4; ++ks) Bfr[wh][ks] = *(const f16x8*)(WT + ((size_t)(nb * 256 + wh * 128 + c) * LB + ks * 32 + 8 * lg));
        const int dc = nb * LB + 8 * chunk8;
        f32x4 cw0[4], cw1[4]; const f32x4 cb0 = *(const f32x4*)(F.inp(I_CLB) + dc), cb1 = *(const f32x4*)(F.inp(I_CLB) + dc + 4);
#pragma unroll
        for (int j = 0; j < 4; ++j) { cw0[j] = *(const f32x4*)(F.inp(I_CLW) + j * DLRU + dc); cw1[j] = *(const f32x4*)(F.inp(I_CLW) + j * DLRU + dc + 4); }
        float carry = 0.f;
        u32x4 xr[2][4], gr[2];
        const u32x4 z4 = {0u, 0u, 0u, 0u};
#define P3_LOAD(tile_) do { _Pragma("unroll") for (int ps = 0; ps < 2; ++ps) { const int t_ = (tile_) * 64 + trow + 32 * ps; \
            _Pragma("unroll") for (int j = 0; j < 4; ++j) { const int ts_ = t_ - 3 + j; xr[ps][j] = z4; if (ts_ >= 0) xr[ps][j] = *(const u32x4*)(XL + (size_t)(b * SEQ + ts_) * DLRU + dc); } \
            gr[ps] = *(const u32x4*)(GT + (size_t)(b * SEQ + t_) * DLRU + dc); } } while (0)
        P3_LOAD(0);
        for (int tile = 0; tile < SEQ / 64; ++tile) {
            const int t0 = tile * 64;
#pragma unroll
            for (int ps = 0; ps < 2; ++ps) {
                const int row = trow + 32 * ps;
                f32x4 v0 = cb0, v1 = cb1;
#pragma unroll
                for (int j = 0; j < 4; ++j) { const u32x4 w = xr[ps][j];
                    const f32x4 x0 = {h2f((u16)(w.x & 0xffffu)), h2f((u16)(w.x >> 16)), h2f((u16)(w.y & 0xffffu)), h2f((u16)(w.y >> 16))};
                    const f32x4 x1 = {h2f((u16)(w.z & 0xffffu)), h2f((u16)(w.z >> 16)), h2f((u16)(w.w & 0xffffu)), h2f((u16)(w.w >> 16))};
                    v0 += cw0[j] * x0; v1 += cw1[j] * x1; }
                *(LAS f32x4*)(xc32 + row * 128 + 8 * chunk8) = v0; *(LAS f32x4*)(xc32 + row * 128 + 8 * chunk8 + 4) = v1;
                u32x4 pk; pk.x = pkh(v0.x, v0.y); pk.y = pkh(v0.z, v0.w); pk.z = pkh(v1.x, v1.y); pk.w = pkh(v1.z, v1.w);
                *(LAS u32x4*)(xc16 + row * 272 + chunk8 * 16) = pk;
                *(LAS u32x4*)(gt16 + row * 128 + 8 * chunk8) = gr[ps];
            }
            __syncthreads();
            if (tile + 1 < SEQ / 64) P3_LOAD(tile + 1);
            f32x4 Cr[4], Ci[4];
#pragma unroll
            for (int mt = 0; mt < 4; ++mt) { f32x4 cr = {0.f, 0.f, 0.f, 0.f}, ci = cr;
#pragma unroll
                for (int ks = 0; ks < 4; ++ks) { const f16x8 a = *(const LAS f16x8*)(xc16 + (16 * mt + cl) * 272 + ks * 64 + lg * 16);
                    cr = __builtin_amdgcn_mfma_f32_16x16x32_f16(a, Bfr[0][ks], cr, 0, 0, 0); ci = __builtin_amdgcn_mfma_f32_16x16x32_f16(a, Bfr[1][ks], ci, 0, 0, 0); }
                Cr[mt] = cr; Ci[mt] = ci; }
#pragma unroll
            for (int mt = 0; mt < 4; ++mt) {
                float av[4], hv[4]; float P = 1.f, S = 0.f;
                {
                    const int tk = 16 * mt + 4 * lg;
                    const f32x4 xv = {xc32[tk * 128 + c], xc32[(tk + 1) * 128 + c], xc32[(tk + 2) * 128 + c], xc32[(tk + 3) * 128 + c]};
                    const f32x4 zr = (Cr[mt] + ba) * -1.4426950408889634f, zi = (Ci[mt] + bx) * -1.4426950408889634f;
                    const f32x4 dr = (f32x4){__builtin_amdgcn_exp2f(zr.x), __builtin_amdgcn_exp2f(zr.y), __builtin_amdgcn_exp2f(zr.z), __builtin_amdgcn_exp2f(zr.w)} + 1.0f;
                    const f32x4 di = (f32x4){__builtin_amdgcn_exp2f(zi.x), __builtin_amdgcn_exp2f(zi.y), __builtin_amdgcn_exp2f(zi.z), __builtin_amdgcn_exp2f(zi.w)} + 1.0f;
                    const f32x4 r = {__builtin_amdgcn_rcpf(dr.x), __builtin_amdgcn_rcpf(dr.y), __builtin_amdgcn_rcpf(dr.z), __builtin_amdgcn_rcpf(dr.w)};
                    const f32x4 ig = {__builtin_amdgcn_rcpf(di.x), __builtin_amdgcn_rcpf(di.y), __builtin_amdgcn_rcpf(di.z), __builtin_amdgcn_rcpf(di.w)};
                    const f32x4 l2 = r * (cdec * 1.4426950408889634f), x2 = r * (2.0f * cdec);
                    const f32x4 a4 = {__builtin_amdgcn_exp2f(l2.x), __builtin_amdgcn_exp2f(l2.y), __builtin_amdgcn_exp2f(l2.z), __builtin_amdgcn_exp2f(l2.w)};
                    const f32x4 om = -x2 * (1.0f + 0.5f * x2 * (1.0f + (1.0f / 3.0f) * x2 * (1.0f + 0.25f * x2 * (1.0f + 0.2f * x2 * (1.0f + (1.0f / 6.0f) * x2)))));
                    const f32x4 u4 = (f32x4){__builtin_amdgcn_sqrtf(om.x), __builtin_amdgcn_sqrtf(om.y), __builtin_amdgcn_sqrtf(om.z), __builtin_amdgcn_sqrtf(om.w)} * (ig * xv);
                    const float ua[4] = {u4.x, u4.y, u4.z, u4.w}, aa[4] = {a4.x, a4.y, a4.z, a4.w};
#pragma unroll
                    for (int e = 0; e < 4; ++e) { S = aa[e] * S + ua[e]; P = P * aa[e]; av[e] = P; hv[e] = S; }
                }
                float Pin = 1.f, Sin = 0.f;
                { float Pq = P, Sq = S;
                  float Pu = shfl_up16(Pq), Su = shfl_up16(Sq); if (lg >= 1) { Sq = Pq * Su + Sq; Pq = Pq * Pu; }
                  Pu = __shfl_up(Pq, 32); Su = __shfl_up(Sq, 32); if (lg >= 2) { Sq = Pq * Su + Sq; Pq = Pq * Pu; }
                  Pu = shfl_up16(Pq); Su = shfl_up16(Sq); if (lg >= 1) { Pin = Pu; Sin = Su; }
                  const float hin = Sin + Pin * carry;
#pragma unroll
                  for (int e = 0; e < 4; ++e) hv[e] = hv[e] + av[e] * hin;
                  carry = __shfl(hv[3], 48 + cl);
                }
                { const int tk = 16 * mt + 4 * lg;
                  const f32x4 gg = gelu_tanh4((f32x4){h2f(gt16[tk * 128 + c]), h2f(gt16[(tk + 1) * 128 + c]), h2f(gt16[(tk + 2) * 128 + c]), h2f(gt16[(tk + 3) * 128 + c])});
                  const float ga4[4] = {gg.x, gg.y, gg.z, gg.w};
#pragma unroll
                  for (int e = 0; e < 4; ++e) { const size_t o = (size_t)(b * SEQ + t0 + tk + e) * DLRU + d; YL[o] = hv[e] * ga4[e]; } }
            }
            __syncthreads();
        }
#undef P3_LOAD
    }
}

__device__ __forceinline__ unsigned f2key(float f) { const unsigned u = __builtin_bit_cast(unsigned, f); return (u & 0x80000000u) ? ~u : (u | 0x80000000u); }
__device__ __forceinline__ int block_sum_i(Frame& F, LAS int* slots, int v) {
    const int w = (int)wave_sum((float)v);
    if (F.lane == 0) slots[F.wave] = w;
    __syncthreads();
    int s = 0;
#pragma unroll
    for (int i = 0; i < 8; ++i) s += slots[i];
    __syncthreads();
    return s;
}
__device__ __forceinline__ void p4_phase(Frame& F) {
    LAS float* qs = (LAS float*)F.lds;
    LAS float* wts = qs + 2048;
    LAS int* slots = (LAS int*)(wts + 32);
    LAS int* cnts = slots + 8;
    LAS int* sel = cnts + 64;
    LAS float* qa = (LAS float*)(sel + 256);
    LAS float* lg = qa + 2048;
    LAS float* red = lg + 4096;
    const u16* QI = (const u16*)(F.ws + WS_QI); const u16* KI = (const u16*)(F.ws + WS_KI); const float* WI = (const float*)(F.ws + WS_WI);
    const u16* Q = (const u16*)(F.ws + WS_Q); const u16* K = (const u16*)(F.ws + WS_K); const u16* V = (const u16*)(F.ws + WS_V);
    u16* MG = (u16*)(F.ws + WS_MERGED);
#if MK_DIAG
    for (int gq = F.bid * 64 + (F.bid * 7) % 64, once = 0; once < 1; ++once) {
#else
    for (int gq = F.bid; gq < M; gq += F.G) {
#endif
        const int b = gq / SEQ, t = gq % SEQ, nvalid = t + 1;
        for (int i = F.tid; i < NIH * IDIM; i += NTHR) qs[i] = h2f(QI[(size_t)gq * (NIH * IDIM) + i]);
        if (F.tid < NIH) wts[F.tid] = WI[(size_t)gq * NIH + F.tid];
        for (int i = F.tid; i < NH * HD; i += NTHR) qa[i] = h2f(Q[(size_t)gq * DATT + i]) * ATT_SCALE;
        __syncthreads();
        unsigned uk[8];
#pragma unroll
        for (int j = 0; j < 8; ++j) {
            const int key = F.tid + 512 * j;
            uk[j] = 0u;
            if (F.wave * 64 + 512 * j <= t) {
                const int kk = key <= t ? key : t;
                const u32x4* kp = (const u32x4*)(KI + (size_t)(b * SEQ + kk) * IDIM);
                float kf[64];
#pragma unroll
                for (int c8 = 0; c8 < 8; ++c8) { const u32x4 w = kp[c8];
                    const unsigned ww[4] = {w.x, w.y, w.z, w.w};
#pragma unroll
                    for (int e = 0; e < 4; ++e) { kf[c8 * 8 + 2 * e] = h2f((u16)(ww[e] & 0xffffu)); kf[c8 * 8 + 2 * e + 1] = h2f((u16)(ww[e] >> 16)); } }
                float score = 0.f;
#pragma unroll 1
                for (int h = 0; h < NIH; ++h) {
                    float d0 = 0.f, d1 = 0.f;
#pragma unroll
                    for (int c4 = 0; c4 < 16; ++c4) { const f32x4 qv = *(const LAS f32x4*)(qs + h * 64 + 4 * c4);
                        d0 += kf[4 * c4] * qv.x + kf[4 * c4 + 1] * qv.y; d1 += kf[4 * c4 + 2] * qv.z + kf[4 * c4 + 3] * qv.w; }
                    score += fmaxf(d0 + d1, 0.f) * wts[h];
                }
                if (key <= t) uk[j] = f2key(score);
            }
        }
#if MK_DIAG
        { bool bad = false;
#pragma unroll
          for (int j = 0; j < 8; ++j) { const unsigned a = uk[j], bq = ((const unsigned*)(F.ws + WS_ACT + 32 * MiB))[(size_t)(gq >> 6) * 4096 + F.tid + 512 * j];
              const float fa = __builtin_bit_cast(float, (a & 0x80000000u) ? (a ^ 0x80000000u) : ~a), fb = __builtin_bit_cast(float, (bq & 0x80000000u) ? (bq ^ 0x80000000u) : ~bq);
              float df = (a == 0u || bq == 0u) ? ((a != bq) ? 1000.0f : 0.f) : fabsf(fa - fb);
              const bool ok = !(a == 0u || bq == 0u); const float sab = wave_sum(ok ? fa * fb : 0.f), sbb = wave_sum(ok ? fb * fb : 0.f); (void)df;
              if (F.lane == 0) { atomicAdd((float*)(F.ws + WS_CTL) + CW_FLAGS + 1, sab); atomicAdd((float*)(F.ws + WS_CTL) + CW_FLAGS + 2, sbb); } }
          bad = false;
          if (__any(bad)) chk_flag(F, 2, true); }
#endif
        int nsel;
        if (nvalid <= TOPK) {
            nsel = nvalid;
            if (F.tid < nvalid) sel[F.tid] = F.tid;
            __syncthreads();
        } else {
            unsigned T = 0u; int cge = 0;
            for (int bit = 31; bit >= 0; --bit) {
                const unsigned cand = T | (1u << bit);
                int c = 0;
#pragma unroll
                for (int j = 0; j < 8; ++j) c += (uk[j] >= cand) ? 1 : 0;
                c = block_sum_i(F, slots, c);
                if (c >= TOPK) { T = cand; cge = c; if (c == TOPK) break; }
            }
            int cgt = 0;
            if (cge > TOPK) { int c = 0;
#pragma unroll
                for (int j = 0; j < 8; ++j) c += (uk[j] > T) ? 1 : 0;
                cgt = block_sum_i(F, slots, c); }
            const unsigned long long lmask = (1ull << F.lane) - 1ull;
            int myoff[8];
#pragma unroll
            for (int j = 0; j < 8; ++j) { const bool f = (cge == TOPK) ? (uk[j] >= T) : (uk[j] > T); const unsigned long long bl = __ballot(f);
                myoff[j] = __popcll(bl & lmask); if (F.lane == 0) cnts[j * 8 + F.wave] = __popcll(bl); }
            __syncthreads();
            { int run = 0;
#pragma unroll
              for (int j = 0; j < 8; ++j) {
#pragma unroll
                for (int w = 0; w < 8; ++w) { const int cv = cnts[j * 8 + w]; if (w == F.wave) myoff[j] += run; run += cv; } } }
#pragma unroll
            for (int j = 0; j < 8; ++j) { const bool f = (cge == TOPK) ? (uk[j] >= T) : (uk[j] > T); if (f && myoff[j] < TOPK) sel[myoff[j]] = F.tid + 512 * j; }
            __syncthreads();
            if (cge > TOPK) {
#pragma unroll
                for (int j = 0; j < 8; ++j) { const bool f = (uk[j] == T); const unsigned long long bl = __ballot(f);
                    myoff[j] = __popcll(bl & lmask); if (F.lane == 0) cnts[j * 8 + F.wave] = __popcll(bl); }
                __syncthreads();
                { int run = 0;
#pragma unroll
                  for (int j = 0; j < 8; ++j) {
#pragma unroll
                    for (int w = 0; w < 8; ++w) { const int cv = cnts[j * 8 + w]; if (w == F.wave) myoff[j] += run; run += cv; } } }
#pragma unroll
                for (int j = 0; j < 8; ++j) { const bool f = (uk[j] == T); if (f && cgt + myoff[j] < TOPK) sel[cgt + myoff[j]] = F.tid + 512 * j; }
                __syncthreads();
            }
            nsel = TOPK;
        }
#if MK_DIAG
        int selsame;
        { const unsigned mine = F.tid < 256 ? (F.tid < nsel ? (unsigned)sel[F.tid] : 0xffffffffu) : 0u, theirs = F.tid < 256 ? ((const unsigned*)(F.ws + WS_ACT))[(size_t)gq * 256 + F.tid] : 0u;
          const int nd = block_sum_i(F, slots, mine != theirs ? 1 : 0);
          selsame = (nd == 0);
          if (nd > 24) chk_flag(F, 0, true); }
#endif
        {
            const int j = F.tid & 255, gp = F.tid >> 8;
            if (j < nsel) {
                const int key = sel[j];
#pragma unroll 1
                for (int gi = 0; gi < 2; ++gi) {
                    const int g = 2 * gp + gi;
                    const u32x4* kp = (const u32x4*)(K + (size_t)(b * SEQ + key) * DKV + g * HD);
                    float d[4] = {0.f, 0.f, 0.f, 0.f};
#pragma unroll 4
                    for (int c8 = 0; c8 < 16; ++c8) { const u32x4 w = kp[c8]; const unsigned ww[4] = {w.x, w.y, w.z, w.w}; float kf[8];
#pragma unroll
                        for (int e = 0; e < 4; ++e) { kf[2 * e] = h2f((u16)(ww[e] & 0xffffu)); kf[2 * e + 1] = h2f((u16)(ww[e] >> 16)); }
#pragma unroll
                        for (int hh = 0; hh < 4; ++hh) { const LAS float* qp = qa + (4 * g + hh) * HD + c8 * 8; const f32x4 q0 = *(const LAS f32x4*)qp, q1 = *(const LAS f32x4*)(qp + 4);
                            d[hh] += kf[0] * q0.x + kf[1] * q0.y + kf[2] * q0.z + kf[3] * q0.w + kf[4] * q1.x + kf[5] * q1.y + kf[6] * q1.z + kf[7] * q1.w; } }
#pragma unroll
                    for (int hh = 0; hh < 4; ++hh) lg[(4 * g + hh) * 256 + j] = d[hh];
                }
            }
        }
        __syncthreads();
#pragma unroll 1
        for (int hi = 0; hi < 2; ++hi) { const int h = 2 * F.wave + hi; float v[4]; float mx = -3.0e38f;
#pragma unroll
            for (int i = 0; i < 4; ++i) { const int j = F.lane + 64 * i; v[i] = (j < nsel) ? lg[h * 256 + j] : -3.0e38f; mx = fmaxf(mx, v[i]); }
            mx = wave_max(mx); float s = 0.f;
#pragma unroll
            for (int i = 0; i < 4; ++i) { const int j = F.lane + 64 * i; v[i] = (j < nsel) ? fast_exp(v[i] - mx) : 0.f; s += v[i]; }
            s = wave_sum(s); const float inv = 1.0f / s;
#pragma unroll
            for (int i = 0; i < 4; ++i) lg[h * 256 + F.lane + 64 * i] = v[i] * inv; }
        __syncthreads();
#if MK_DIAG
        if (selsame) { bool bad = false;
            for (int k = F.tid; k < 2048; k += NTHR) { const int jp = k >> 4, h = k & 15; const unsigned w = ((const unsigned*)(F.ws + WS_ACT + 40 * MiB))[(size_t)(gq >> 6) * 2048 + k];
                const float p0 = h2f((u16)(w & 0xffffu)), p1 = h2f((u16)(w >> 16));
                const float r0 = (2 * jp < nsel) ? lg[h * 256 + 2 * jp] : 0.f, r1 = (2 * jp + 1 < nsel) ? lg[h * 256 + 2 * jp + 1] : 0.f;
                bad |= !(fabsf(p0 - r0) <= 0.01f * r0 + 2e-4f) || !(fabsf(p1 - r1) <= 0.01f * r1 + 2e-4f); }
            if (__any(bad)) chk_flag(F, 3, true); }
#endif
        {
            const int g = F.tid >> 7, d = F.tid & 127;
            float o[4] = {0.f, 0.f, 0.f, 0.f};
            const u16* vb = V + (size_t)b * SEQ * DKV + g * HD + d;
#pragma unroll 8
            for (int j = 0; j < nsel; ++j) { const float vv = h2f(vb[(size_t)sel[j] * DKV]);
#pragma unroll
                for (int hh = 0; hh < 4; ++hh) o[hh] += lg[(4 * g + hh) * 256 + j] * vv; }
            float ss = (o[0] * o[0] + o[1] * o[1]) + (o[2] * o[2] + o[3] * o[3]);
            ss = wave_sum(ss);
            if (F.lane == 0) red[F.wave] = ss;
            __syncthreads();
            float tot = 0.f;
#pragma unroll
            for (int i = 0; i < 8; ++i) tot += red[i];
            const float rstd = 1.0f / sqrtf(tot * (1.0f / DATT) + RMS_EPS);
            const float* ga = F.inp(I_GATTN);
#if MK_DIAG
            { bool bad = false;
#pragma unroll
              for (int hh = 0; hh < 4; ++hh) { const int idx = (4 * g + hh) * HD + d; const float ref = o[hh] * rstd * ga[idx], got = h2f(MG[(size_t)gq * DM + DLRU + idx]); bad |= !(fabsf(got - ref) <= 0.02f * fabsf(ref) + 0.02f); }
              if (selsame && __any(bad)) chk_flag(F, 1, true); }
#else
#pragma unroll
            for (int hh = 0; hh < 4; ++hh) { const int idx = (4 * g + hh) * HD + d; MG[(size_t)gq * DM + DLRU + idx] = __builtin_bit_cast(u16, (f16)(o[hh] * rstd * ga[idx])); }
#endif
        }
        __syncthreads();
    }
}

typedef float f32x16 __attribute__((ext_vector_type(16)));
__device__ __forceinline__ void p4_fast(Frame& F) {
    LAS unsigned char* kring = F.lds;
    LAS unsigned* selw = (LAS unsigned*)(F.lds + 65536 + F.wave * 1024);
    const int lane = F.lane, r32 = lane & 31, hi = lane >> 5, head = lane & 15, kq = lane >> 4;
    const u16* QI = (const u16*)(F.ws + WS_QI); const u16* KI = (const u16*)(F.ws + WS_KI); const float* WI = (const float*)(F.ws + WS_WI);
    const u16* Q = (const u16*)(F.ws + WS_Q); const u16* K = (const u16*)(F.ws + WS_K); const u16* V = (const u16*)(F.ws + WS_V);
    u16* MG = (u16*)(F.ws + WS_MERGED);
    const int srow = F.tid >> 3, scol = ((F.tid & 7) ^ ((srow >> 1) & 7)) * 8;
    int rdoff[4];
#pragma unroll
    for (int ks = 0; ks < 4; ++ks) rdoff[ks] = r32 * 128 + (((2 * ks + hi) ^ ((r32 >> 1) & 7)) * 16);
    const unsigned long long lmask = (1ull << lane) - 1ull;
    LAS int* qslot = (LAS int*)(F.lds + 73728 + 8 * 8704);
    for (;;) {
        asm volatile("s_waitcnt lgkmcnt(0)" ::: "memory"); __builtin_amdgcn_s_barrier(); asm volatile("" ::: "memory");
        if (F.tid == 0) *qslot = (int)__hip_atomic_fetch_add((unsigned*)(F.ws + WS_CTL) + CW_QUEUE, 1u, __ATOMIC_RELAXED, __HIP_MEMORY_SCOPE_AGENT);
        asm volatile("s_waitcnt lgkmcnt(0)" ::: "memory"); __builtin_amdgcn_s_barrier(); asm volatile("" ::: "memory");
        const int it = *qslot; if (it >= M / 8) break;
        const int b = it >> 9, gi = 511 - (it & 511);
        const int t0 = gi * 8, t = t0 + F.wave, gq = b * SEQ + t, NT = (t0 >> 6) + 1, nvalid = t + 1;
        const u16* kb = KI + (size_t)b * SEQ * IDIM;
#define P4_STAGE(i) __builtin_amdgcn_global_load_lds((const unsigned*)(kb + (size_t)(64 * (i) + srow) * IDIM + scol), (LAS unsigned*)(kring + ((i) & 7) * 8192 + F.wave * 1024), 16, 0, 0)
#if !P4_DIRECT
        P4_STAGE(0); if (1 < NT) P4_STAGE(1); if (2 < NT) P4_STAGE(2); if (3 < NT) P4_STAGE(3); if (4 < NT) P4_STAGE(4); if (5 < NT) P4_STAGE(5);
#endif
        f16x8 qa[4]; float wreg[16];
#pragma unroll
        for (int ks = 0; ks < 4; ++ks) qa[ks] = *(const f16x8*)(QI + (size_t)gq * (NIH * IDIM) + r32 * IDIM + ks * 16 + hi * 8);
#pragma unroll
        for (int r = 0; r < 16; ++r) wreg[r] = WI[(size_t)gq * NIH + (r & 3) + 8 * (r >> 2) + 4 * hi];
        unsigned uk[64];
#define P4_SCORE(i_) do { const LAS unsigned char* slot = kring + ((i_) & 7) * 8192; float sA = 0.f, sB = 0.f; \
                {                                                     \
                    f16x8 bfa[4], bfb[4]; \
                    _Pragma("unroll") for (int ks = 0; ks < 4; ++ks) { bfa[ks] = *(const LAS f16x8*)(slot + rdoff[ks]); bfb[ks] = *(const LAS f16x8*)(slot + 4096 + rdoff[ks]); } \
                    f32x16 accA = {}, accB = {}; f32x2 pA = {0.f, 0.f}, pB = {0.f, 0.f}; \
                    _Pragma("unroll") for (int ks = 0; ks < 4; ++ks) { accA = __builtin_amdgcn_mfma_f32_32x32x16_f16(qa[ks], bfa[ks], accA, 0, 0, 0); accB = __builtin_amdgcn_mfma_f32_32x32x16_f16(qa[ks], bfb[ks], accB, 0, 0, 0); } \
                    _Pragma("unroll") for (int r = 0; r < 16; r += 2) { const f32x2 w2 = {wreg[r], wreg[r + 1]};                         \
                        const f32x2 ra = {__builtin_amdgcn_fmed3f(accA[r], 0.f, 3.0e38f), __builtin_amdgcn_fmed3f(accA[r + 1], 0.f, 3.0e38f)}, rb = {__builtin_amdgcn_fmed3f(accB[r], 0.f, 3.0e38f), __builtin_amdgcn_fmed3f(accB[r + 1], 0.f, 3.0e38f)}; \
                        pA += ra * w2; pB += rb * w2; } \
                    sA = pA.x + pA.y; sB = pB.x + pB.y; \
                } \
                const auto sw = __builtin_amdgcn_permlane32_swap(__builtin_bit_cast(unsigned, sA), __builtin_bit_cast(unsigned, sB), false, false); \
                const unsigned sw0 = sw[0], sw1 = sw[1];                   \
                const float score = __uint_as_float(sw0) + __uint_as_float(sw1);     \
                uk[i_] = (64 * (i_) + lane <= t) ? f2key(score) : 0u; } while (0)
#pragma unroll
        for (int ip = 0; ip < 32; ++ip) {
            uk[2 * ip] = 0u; uk[2 * ip + 1] = 0u;
            if (2 * ip < NT) {
                { const int last = (2 * ip + 1 < NT) ? 2 * ip + 1 : 2 * ip, yg = NT - 1 - last;
                  if (yg >= 4) asm volatile("s_waitcnt vmcnt(4) lgkmcnt(0)" ::: "memory"); else if (yg == 3) asm volatile("s_waitcnt vmcnt(3) lgkmcnt(0)" ::: "memory");
                  else if (yg == 2) asm volatile("s_waitcnt vmcnt(2) lgkmcnt(0)" ::: "memory"); else if (yg == 1) asm volatile("s_waitcnt vmcnt(1) lgkmcnt(0)" ::: "memory");
                  else asm volatile("s_waitcnt vmcnt(0) lgkmcnt(0)" ::: "memory"); }
                __builtin_amdgcn_s_barrier(); asm volatile("" ::: "memory");
                if (2 * ip + 6 < NT) P4_STAGE(2 * ip + 6);
                if (2 * ip + 7 < NT) P4_STAGE(2 * ip + 7);
                P4_SCORE(2 * ip);
                if (2 * ip + 1 < NT) P4_SCORE(2 * ip + 1);
            }
        }
#undef P4_SCORE
#if MK_DIAG
        if ((((gq >> 6) * 7) & 63) == (gq & 63)) {
#pragma unroll
            for (int i = 0; i < 64; ++i) ((unsigned*)(F.ws + WS_ACT + 32 * MiB))[(size_t)(gq >> 6) * 4096 + 64 * i + lane] = uk[i]; }
#endif
        int nsel;
        if (nvalid <= TOPK) {
            nsel = nvalid;
#pragma unroll
            for (int k = 0; k < 4; ++k) { const int j = lane + 64 * k; selw[j] = j < nvalid ? (unsigned)j : 0u; }
        } else {
            unsigned mx = 0u;
#pragma unroll
            for (int i8 = 0; i8 < 8; ++i8) if (8 * i8 < NT) {
#pragma unroll
                for (int i = 8 * i8; i < 8 * i8 + 8; ++i) mx = uk[i] > mx ? uk[i] : mx; }
#pragma unroll
            for (int off = 32; off >= 1; off >>= 1) { const unsigned o = (unsigned)__shfl_xor((int)mx, off); mx = o > mx ? o : mx; }
            mx = (unsigned)__builtin_amdgcn_readfirstlane((int)mx);
#if MK_SELREP
#pragma unroll 1
            for (int rep = 0; rep < MK_SELREP; ++rep) {
                unsigned Lk = 1u, Hk = mx + 1u; int cl = nvalid, nstep = 0, last = 0; unsigned stepc = mx & 0xFF800000u; float fl = (float)cl - 255.5f, fh = -255.5f;
                for (;;) {
                    if (cl == TOPK || Hk - Lk == 1u) break;
                    const unsigned w = Hk - Lk; const bool stepping = nstep < 3 && stepc > Lk; unsigned cand;
                    if (stepping) cand = stepc; else if (w > 0x00800000u) cand = Lk + (w >> 1); else cand = Lk + (unsigned)((float)w * (fl * __builtin_amdgcn_rcpf(fl - fh)));
                    cand = cand < Lk + 1u ? Lk + 1u : cand; cand = cand > Hk - 1u ? Hk - 1u : cand;
                    int c;
                    { unsigned acc = 0u;
#pragma unroll
                      for (int i8 = 0; i8 < 8; ++i8) if (8 * i8 < NT) {
#pragma unroll
                          for (int i = 8 * i8; i < 8 * i8 + 8; ++i) acc += (uk[i] >= cand) ? 1u : 0u; }
                      int a = (int)acc;
                      a += __builtin_amdgcn_update_dpp(0, a, 0x128, 0xf, 0xf, false); a += __builtin_amdgcn_update_dpp(0, a, 0x124, 0xf, 0xf, false);
                      a += __builtin_amdgcn_update_dpp(0, a, 0x122, 0xf, 0xf, false); a += __builtin_amdgcn_update_dpp(0, a, 0x121, 0xf, 0xf, false);
                      c = __builtin_amdgcn_readlane(a, 0) + __builtin_amdgcn_readlane(a, 16) + __builtin_amdgcn_readlane(a, 32) + __builtin_amdgcn_readlane(a, 48); }
                    if (c >= TOPK) { Lk = cand; cl = c; fl = (float)c - 255.5f; if (stepping) nstep = 3; else { if (last == 1) fh *= 0.5f; last = 1; } }
                    else { Hk = cand; fh = (float)c - 255.5f; if (stepping) { ++nstep; stepc = cand > 0x00800000u ? cand - 0x00800000u : 0u; } else { if (last == 2) fl *= 0.5f; last = 2; } }
                }
                asm volatile("" : "+v"(uk[0]), "+v"(uk[1]) : "s"(Lk));
            }
#endif
            unsigned Lk = 1u, Hk = mx + 1u, T = 0u; int cl = nvalid, ch = 0, cge = 0, nstep = 0, last = 0;
            unsigned stepc = mx & 0xFF800000u; float fl = (float)cl - 255.5f, fh = -255.5f;
            for (;;) {
                if (cl == TOPK || Hk - Lk == 1u) { T = Lk; cge = cl; break; }
                const unsigned w = Hk - Lk; const bool stepping = nstep < 3 && stepc > Lk;
                unsigned cand;
                if (stepping) cand = stepc;
                else if (w > 0x00800000u) cand = Lk + (w >> 1);
                else cand = Lk + (unsigned)((float)w * (fl * __builtin_amdgcn_rcpf(fl - fh)));
                cand = cand < Lk + 1u ? Lk + 1u : cand; cand = cand > Hk - 1u ? Hk - 1u : cand;
                int c;
                { unsigned acc = 0u;
#pragma unroll
                  for (int i8 = 0; i8 < 8; ++i8) if (8 * i8 < NT) {
#pragma unroll
                      for (int i = 8 * i8; i < 8 * i8 + 8; ++i) acc += (uk[i] >= cand) ? 1u : 0u; }
                  int a = (int)acc;
                  a += __builtin_amdgcn_update_dpp(0, a, 0x128, 0xf, 0xf, false); a += __builtin_amdgcn_update_dpp(0, a, 0x124, 0xf, 0xf, false);
                  a += __builtin_amdgcn_update_dpp(0, a, 0x122, 0xf, 0xf, false); a += __builtin_amdgcn_update_dpp(0, a, 0x121, 0xf, 0xf, false);
                  c = __builtin_amdgcn_readlane(a, 0) + __builtin_amdgcn_readlane(a, 16) + __builtin_amdgcn_readlane(a, 32) + __builtin_amdgcn_readlane(a, 48); }
                if (c >= TOPK) { Lk = cand; cl = c; fl = (float)c - 255.5f; if (stepping) nstep = 3; else { if (last == 1) fh *= 0.5f; last = 1; } }
                else { Hk = cand; ch = c; fh = (float)c - 255.5f; if (stepping) { ++nstep; stepc = cand > 0x00800000u ? cand - 0x00800000u : 0u; } else { if (last == 2) fl *= 0.5f; last = 2; } }
            }
            int base = 0;
#pragma unroll
            for (int i8 = 0; i8 < 8; ++i8) if (8 * i8 < NT) {
#pragma unroll
                for (int i = 8 * i8; i < 8 * i8 + 8; ++i) { const bool f = (cge == TOPK) ? (uk[i] >= T) : (uk[i] > T); const unsigned long long bl = __ballot(f);
                    const int pos = base + __popcll(bl & lmask); if (f && pos < TOPK) selw[pos] = (unsigned)(64 * i + lane); base += __popcll(bl); } }
            if (cge > TOPK) {
#pragma unroll
                for (int i8 = 0; i8 < 8; ++i8) if (8 * i8 < NT) {
#pragma unroll
                    for (int i = 8 * i8; i < 8 * i8 + 8; ++i) { const bool f = (uk[i] == T); const unsigned long long bl = __ballot(f);
                        const int pos = base + __popcll(bl & lmask); if (f && pos < TOPK) selw[pos] = (unsigned)(64 * i + lane); base += __popcll(bl); } }
            }
            nsel = TOPK;
        }
        asm volatile("s_waitcnt lgkmcnt(0)" ::: "memory");
#if MK_DIAG
#pragma unroll
        for (int k = 0; k < 4; ++k) ((unsigned*)(F.ws + WS_ACT))[(size_t)gq * 256 + lane + 64 * k] = (lane + 64 * k < nsel) ? selw[lane + 64 * k] : 0xffffffffu;
#endif
        f32x4 C[16];
        {
            long q8[2][2];
#pragma unroll
            for (int ks2 = 0; ks2 < 2; ++ks2)
#pragma unroll
                for (int hf = 0; hf < 2; ++hf) q8[ks2][hf] = *(const long*)((const unsigned char*)Q + (size_t)gq * DATT + head * HD + 64 * ks2 + 16 * kq + 8 * hf);
            const int hg = head >> 2;
            const unsigned char* K8 = (const unsigned char*)K;
            LAS unsigned char* kst = F.lds + 73728 + F.wave * 8704;
            const int l5 = lane >> 5, p32 = lane & 31;
            LAS unsigned char* kw = kst + (8 * l5) * 528 + 16 * p32;
            const LAS unsigned char* kr = kst + head * 528 + 16 * kq;
            u32x4 kbuf[3][8];
#define P4_QK_LOAD(dst_, t_) do { const u32x4 ka_ = *(const LAS u32x4*)(selw + 16 * (t_) + 8 * l5), kb_ = *(const LAS u32x4*)(selw + 16 * (t_) + 8 * l5 + 4); \
                const unsigned kk_[8] = {ka_.x, ka_.y, ka_.z, ka_.w, kb_.x, kb_.y, kb_.z, kb_.w}; const unsigned char* p_ = K8 + (size_t)b * SEQ * DKV + 16 * p32; \
                _Pragma("unroll") for (int i_ = 0; i_ < 8; ++i_) dst_[i_] = *(const u32x4*)(p_ + (size_t)kk_[i_] * DKV); } while (0)
            P4_QK_LOAD(kbuf[0], 0); P4_QK_LOAD(kbuf[1], 1);
#pragma unroll
            for (int t = 0; t < 16; ++t) {
                if (t + 2 < 16) P4_QK_LOAD(kbuf[(t + 2) % 3], t + 2);
                asm volatile("" ::: "memory");
#pragma unroll
                for (int i_ = 0; i_ < 8; ++i_) *(LAS u32x4*)(kw + 528 * i_) = kbuf[t % 3][i_];
                asm volatile("s_waitcnt lgkmcnt(0)" ::: "memory");
                f32x4 c0 = {0.f, 0.f, 0.f, 0.f};
#pragma unroll
                for (int g = 0; g < 4; ++g)
#pragma unroll
                    for (int ks2 = 0; ks2 < 2; ++ks2) {
                        const u32x4 a0 = *(const LAS u32x4*)(kr + g * HD + ks2 * 64);
                        const long a0l = (long)(((unsigned long long)a0.y << 32) | a0.x), a0h = (long)(((unsigned long long)a0.w << 32) | a0.z);
                        const long b0 = (hg == g) ? q8[ks2][0] : 0l, b1 = (hg == g) ? q8[ks2][1] : 0l;
                        c0 = __builtin_amdgcn_mfma_f32_16x16x32_fp8_fp8(a0l, b0, c0, 0, 0, 0); c0 = __builtin_amdgcn_mfma_f32_16x16x32_fp8_fp8(a0h, b1, c0, 0, 0, 0); }
                C[t] = c0;
                asm volatile("s_waitcnt lgkmcnt(0)" ::: "memory");
            }
#undef P4_QK_LOAD
        }
        long Pf[8];
        {
            const float C2 = ATT_SCALE * 1.4426950408889634f * (1.0f / 64.0f); const float NEG = -__builtin_inff();
            float mx = NEG;
#pragma unroll
            for (int tile = 0; tile < 16; ++tile)
#pragma unroll
                for (int e = 0; e < 4; ++e) { const int sl = 16 * tile + 4 * kq + e; const float v = sl < nsel ? C[tile][e] : NEG; C[tile][e] = v; mx = fmaxf(mx, v); }
            mx = fmaxf(mx, __shfl_xor(mx, 16)); mx = fmaxf(mx, __shfl_xor(mx, 32));
            float sum = 0.f;
#pragma unroll
            for (int tile = 0; tile < 16; ++tile)
#pragma unroll
                for (int e = 0; e < 4; ++e) { const float p = __builtin_amdgcn_exp2f((C[tile][e] - mx) * C2); C[tile][e] = p; sum += p; }
            sum += __shfl_xor(sum, 16); sum += __shfl_xor(sum, 32);
            const float inv = 256.0f / sum;
#pragma unroll
            for (int ks = 0; ks < 8; ++ks) {
                const f32x4 a = C[2 * ks] * inv, bq = C[2 * ks + 1] * inv;
                int lo = __builtin_amdgcn_cvt_pk_fp8_f32(a.x, a.y, 0, false); lo = __builtin_amdgcn_cvt_pk_fp8_f32(a.z, a.w, lo, true);
                int hi2 = __builtin_amdgcn_cvt_pk_fp8_f32(bq.x, bq.y, 0, false); hi2 = __builtin_amdgcn_cvt_pk_fp8_f32(bq.z, bq.w, hi2, true);
                Pf[ks] = (long)(((unsigned long long)(unsigned)hi2 << 32) | (unsigned long long)(unsigned)lo); }
        }
        f32x4 Od[8];
#pragma unroll
        for (int d = 0; d < 8; ++d) Od[d] = (f32x4){0.f, 0.f, 0.f, 0.f};
        {
            LAS unsigned char* vst = F.lds + 73728 + F.wave * 8704;
            const unsigned char* V8 = (const unsigned char*)V;
            const int vrow = lane & 31, vhalf = lane >> 5, i16 = lane & 15, trr = i16 >> 1;
            const int trR = (trr < 4) ? (4 * kq + trr) : (16 + 4 * kq + (trr - 4));
            const LAS unsigned char* trbase = vst + trR * 272 + 8 * (i16 & 1);
            LAS unsigned char* wbase = vst + (8 * kq) * 272 + 16 * i16;
            const int hg = head >> 2;
            u32x4 vbuf[4][8];
#define P4_PV_LOAD(dst_, s_) do { const u32x4 ka_ = *(const LAS u32x4*)(selw + 32 * ((s_) >> 1) + 8 * kq), kb_ = *(const LAS u32x4*)(selw + 32 * ((s_) >> 1) + 8 * kq + 4); \
                const unsigned kk_[8] = {ka_.x, ka_.y, ka_.z, ka_.w, kb_.x, kb_.y, kb_.z, kb_.w}; const unsigned char* p_ = V8 + (size_t)b * SEQ * DKV + ((s_) & 1) * 256 + 16 * i16; \
                _Pragma("unroll") for (int i_ = 0; i_ < 8; ++i_) dst_[i_] = *(const u32x4*)(p_ + (size_t)kk_[i_] * DKV); } while (0)
#define P4_PV_MATH(src_, s_) do { asm volatile("" ::: "memory"); _Pragma("unroll") for (int i_ = 0; i_ < 8; ++i_) *(LAS u32x4*)(wbase + 272 * i_) = src_[i_]; \
                asm volatile("s_waitcnt lgkmcnt(0)" ::: "memory"); \
                _Pragma("unroll") for (int gi_ = 0; gi_ < 2; ++gi_) { const long bm_ = (hg == 2 * ((s_) & 1) + gi_) ? Pf[(s_) >> 1] : 0l; \
                    _Pragma("unroll") for (int d_ = 0; d_ < 8; ++d_) { const i32x2 t_ = __builtin_amdgcn_ds_read_tr8_b64_v2i32((i32x2 LAS*)(trbase + gi_ * 128 + d_ * 16)); \
                        const long a_ = (long)(((unsigned long long)(unsigned)t_.y << 32) | (unsigned long long)(unsigned)t_.x); \
                        Od[d_] = __builtin_amdgcn_mfma_f32_16x16x32_fp8_fp8(a_, bm_, Od[d_], 0, 0, 0); } } \
                asm volatile("s_waitcnt lgkmcnt(0)" ::: "memory"); } while (0)
            P4_PV_LOAD(vbuf[0], 0); P4_PV_LOAD(vbuf[1], 1); P4_PV_LOAD(vbuf[2], 2);
#pragma unroll
            for (int s = 0; s < 16; ++s) {
                if (s + 3 < 16) P4_PV_LOAD(vbuf[(s + 3) & 3], s + 3);
                P4_PV_MATH(vbuf[s & 3], s);
            }
#undef P4_PV_LOAD
#undef P4_PV_MATH
        }
        float ss = 0.f;
#pragma unroll
        for (int d = 0; d < 8; ++d) ss += (Od[d].x * Od[d].x + Od[d].y * Od[d].y) + (Od[d].z * Od[d].z + Od[d].w * Od[d].w);
        const float rstd = 1.0f / sqrtf(wave_sum(ss) * (1.0f / DATT) + RMS_EPS);
        const float* ga = F.inp(I_GATTN);
        f32x4 gvv[8];
#pragma unroll
        for (int d = 0; d < 8; ++d) gvv[d] = *(const f32x4*)(ga + head * HD + 16 * d + 4 * kq);
#pragma unroll
        for (int d = 0; d < 8; ++d) { const int idx = head * HD + 16 * d + 4 * kq; const f32x4 gv = gvv[d];
            const float r8 = 8.0f * rstd;
            *(unsigned*)((unsigned char*)MG + (size_t)gq * DM + DLRU + idx) = (pg8::cvt2_fp8(sat8(Od[d].x * r8 * gv.x), sat8(Od[d].y * r8 * gv.y)) & 0xffffu) | (pg8::cvt2_fp8(sat8(Od[d].z * r8 * gv.z), sat8(Od[d].w * r8 * gv.w)) << 16); }
#undef P4_STAGE
    }
}

__device__ __forceinline__ void p5_phase(Frame& F) {
    const float* YL = (const float*)(F.ws + WS_YL); u16* MG = (u16*)(F.ws + WS_MERGED);
    LAS f32x4* va = (LAS f32x4*)F.lds;
    __syncthreads();
    for (int i = F.tid; i < DLRU / 4; i += NTHR) va[i] = ((const f32x4*)F.inp(I_GLRU))[i];
    __syncthreads();
    for (int blk = F.bid; blk < M / 64; blk += F.G) {
        const int row0 = blk * 64 + F.wave * 8;
        f32x4 nx[8];
#pragma unroll
        for (int j = 0; j < 8; ++j) nx[j] = ((const f32x4*)(YL + (size_t)row0 * DLRU) + F.lane)[64 * j];
#pragma unroll 1
        for (int ri = 0; ri < 8; ++ri) {
            const int row = row0 + ri;
            f32x4 v[8]; float s = 0.f;
#pragma unroll
            for (int j = 0; j < 8; ++j) { v[j] = nx[j]; s += (v[j].x * v[j].x + v[j].y * v[j].y) + (v[j].z * v[j].z + v[j].w * v[j].w); }
            if (ri < 7) {
#pragma unroll
                for (int j = 0; j < 8; ++j) nx[j] = ((const f32x4*)(YL + (size_t)(row + 1) * DLRU) + F.lane)[64 * j]; }
            const float rstd = 1.0f / sqrtf(wave_sum(s) * (1.0f / DLRU) + RMS_EPS);
            unsigned* o = (unsigned*)((unsigned char*)MG + (size_t)row * DM) + F.lane;
#pragma unroll
            for (int j = 0; j < 8; ++j) { const f32x4 y = v[j] * (8.0f * rstd) * va[F.lane + 64 * j]; o[64 * j] = (pg8::cvt2_fp8(sat8(y.x), sat8(y.y)) & 0xffffu) | (pg8::cvt2_fp8(sat8(y.z), sat8(y.w)) << 16); }
        }
    }
}

__device__ __forceinline__ void p7_phase(Frame& F) {
    const float* mod = (const float*)(F.ws + WS_MOD); const u16* MIX = (const u16*)(F.ws + WS_MIX); u16* H = (u16*)(F.ws + WS_H);
    LAS f32x4* va = (LAS f32x4*)F.lds; LAS f32x4* vb = va + DM / 4; LAS f32x4* vc = vb + DM / 4;
    for (int blk = F.bid; blk < M / 64; blk += F.G) {
        const int b = (blk * 64) / SEQ;
        __syncthreads();
        for (int i = F.tid; i < DM / 4; i += NTHR) { va[i] = ((const f32x4*)(mod + b * NMOD + 2 * DM))[i] * ((const f32x4*)F.inp(I_GPOSTMIX))[i];
            vb[i] = ((const f32x4*)F.inp(I_GPREFFN))[i] * (1.0f + ((const f32x4*)(mod + b * NMOD + 4 * DM))[i]); vc[i] = ((const f32x4*)(mod + b * NMOD + 3 * DM))[i]; }
        __syncthreads();
        const int row0 = blk * 64 + F.wave * 8;
        u32x2 mw[16]; f32x4 xv[16];
#pragma unroll
        for (int j = 0; j < 16; ++j) mw[j] = *(const u32x2*)(MIX + (size_t)row0 * DM + 4 * F.lane + 256 * j);
#pragma unroll
        for (int j = 0; j < 16; ++j) xv[j] = ((const f32x4*)(F.inp(I_X) + (size_t)row0 * DM) + F.lane)[64 * j];
#pragma unroll 1
        for (int ri = 0; ri < 8; ++ri) {
            const int row = row0 + ri;
            f32x4 v[16]; float s = 0.f;
#pragma unroll
            for (int j = 0; j < 16; ++j) { v[j] = (f32x4){__builtin_bit_cast(float, mw[j].x << 16), __builtin_bit_cast(float, mw[j].x & 0xffff0000u), __builtin_bit_cast(float, mw[j].y << 16), __builtin_bit_cast(float, mw[j].y & 0xffff0000u)};
                s += (v[j].x * v[j].x + v[j].y * v[j].y) + (v[j].z * v[j].z + v[j].w * v[j].w); }
            const float rstd = 1.0f / sqrtf(wave_sum(s) * (1.0f / DM) + RMS_EPS);
            u32x2* xo = (u32x2*)((u16*)(F.ws + WS_MERGED) + (size_t)row * DM) + F.lane; float s2 = 0.f;
#pragma unroll
            for (int j = 0; j < 16; ++j) { v[j] = xv[j] + va[F.lane + 64 * j] * (v[j] * rstd); { u32x2 w; w.x = pkb(v[j].x, v[j].y); w.y = pkb(v[j].z, v[j].w); xo[64 * j] = w; } s2 += (v[j].x * v[j].x + v[j].y * v[j].y) + (v[j].z * v[j].z + v[j].w * v[j].w); }
            if (ri < 7) {
#pragma unroll
                for (int j = 0; j < 16; ++j) mw[j] = *(const u32x2*)(MIX + (size_t)(row + 1) * DM + 4 * F.lane + 256 * j);
#pragma unroll
                for (int j = 0; j < 16; ++j) xv[j] = ((const f32x4*)(F.inp(I_X) + (size_t)(row + 1) * DM) + F.lane)[64 * j]; }
            const float rstd2 = 1.0f / sqrtf(wave_sum(s2) * (1.0f / DM) + RMS_EPS);
            unsigned* o = (unsigned*)((unsigned char*)H + (size_t)row * DM) + F.lane;
            float am = 0.f;
#pragma unroll
            for (int j = 0; j < 16; ++j) { const f32x4 y = v[j] * rstd2 * vb[F.lane + 64 * j] + vc[F.lane + 64 * j]; am = fmaxf(fmaxf(am, fmaxf(fabsf(y.x), fabsf(y.y))), fmaxf(fabsf(y.z), fabsf(y.w))); }
#pragma unroll
            for (int off = 32; off >= 1; off >>= 1) am = fmaxf(am, __shfl_xor(am, off));
            const float qs = am > 0.f ? am * (1.0f / 127.0f) : 1.0f, qi = 1.0f / qs;
            if (F.lane == 0) ((float*)(F.ws + WS_SA_H2))[row] = qs;
#pragma unroll
            for (int j = 0; j < 16; ++j) { const f32x4 y = (v[j] * rstd2 * vb[F.lane + 64 * j] + vc[F.lane + 64 * j]) * qi;
                const int q0 = __float2int_rn(y.x), q1 = __float2int_rn(y.y), q2 = __float2int_rn(y.z), q3 = __float2int_rn(y.w);
                o[64 * j] = (unsigned)(q0 & 255) | ((unsigned)(q1 & 255) << 8) | ((unsigned)(q2 & 255) << 16) | ((unsigned)q3 << 24); }
        }
    }
}

__device__ __forceinline__ void p9_phase(Frame& F) {
    const float* halo = (const float*)(F.ws + WS_HALO); u16* act = (u16*)(F.ws + WS_ACT); const float* cw = F.inp(I_CFW); const float* cb = F.inp(I_CFB);
    const int NQ = DFF / 4, NIT = 128 * 2 * NQ, stride = F.G * NTHR;
#define P9_LOAD(L_, it_) do { const int f4_ = (it_) % NQ, rj_ = (it_) / NQ, r_ = rj_ >> 1, f_ = 4 * f4_; const bool hp_ = (r_ % 32) != 0; const f32x4 z_ = {0.f, 0.f, 0.f, 0.f}; \
        _Pragma("unroll") for (int bj = 0; bj < 2; ++bj) { const int col = bj * DFF + f_; \
            L_[bj][0] = hp_ ? *(const f32x4*)(halo + ((size_t)(r_ - 1) * 4 + 2) * DFF2 + col) : z_; L_[bj][1] = hp_ ? *(const f32x4*)(halo + ((size_t)(r_ - 1) * 4 + 3) * DFF2 + col) : z_; \
            L_[bj][2] = *(const f32x4*)(halo + ((size_t)r_ * 4 + 0) * DFF2 + col); L_[bj][3] = *(const f32x4*)(halo + ((size_t)r_ * 4 + 1) * DFF2 + col); \
            L_[bj][4] = *(const f32x4*)(cw + col); L_[bj][5] = *(const f32x4*)(cw + DFF2 + col); L_[bj][6] = *(const f32x4*)(cw + 2 * DFF2 + col); L_[bj][7] = *(const f32x4*)(cb + col); } } while (0)
#define P9_FINISH(L_, it_) do { const int f4_ = (it_) % NQ, rj_ = (it_) / NQ, jj_ = rj_ & 1, r_ = rj_ >> 1, f_ = 4 * f4_; f32x4 res_[2]; \
        _Pragma("unroll") for (int bj = 0; bj < 2; ++bj) res_[bj] = jj_ ? (L_[bj][7] + L_[bj][4] * L_[bj][1] + L_[bj][5] * L_[bj][2] + L_[bj][6] * L_[bj][3]) : (L_[bj][7] + L_[bj][4] * L_[bj][0] + L_[bj][5] * L_[bj][1] + L_[bj][6] * L_[bj][2]); \
        const f32x4 a_ = gelu_tanh4(res_[0]) * res_[1] * 2.0f; \
        int w_ = __builtin_amdgcn_cvt_pk_fp8_f32(sat8(a_.x), sat8(a_.y), 0, false); w_ = __builtin_amdgcn_cvt_pk_fp8_f32(sat8(a_.z), sat8(a_.w), w_, true); \
        *(unsigned*)((unsigned char*)act + (size_t)(128 * r_ + jj_) * DFF + f_) = (unsigned)w_; } while (0)
    for (int it = F.bid * NTHR + F.tid; it < NIT; it += 2 * stride) {
        f32x4 LA[2][8], LB[2][8]; const int itb = it + stride; const bool hb = itb < NIT;
        P9_LOAD(LA, it);
        if (hb) P9_LOAD(LB, itb);
        P9_FINISH(LA, it);
        if (hb) P9_FINISH(LB, itb);
    }
#undef P9_LOAD
#undef P9_FINISH
}

__device__ __forceinline__ void p11_phase(Frame& F) {
    const float* mod = (const float*)(F.ws + WS_MOD); const u16* FF = (const u16*)(F.ws + WS_MIX);
    LAS f32x4* va = (LAS f32x4*)F.lds;
    for (int blk = F.bid; blk < M / 64; blk += F.G) {
        const int b = (blk * 64) / SEQ;
        __syncthreads();
        for (int i = F.tid; i < DM / 4; i += NTHR) va[i] = ((const f32x4*)(mod + b * NMOD + 5 * DM))[i] * ((const f32x4*)F.inp(I_GPOSTFFN))[i];
        __syncthreads();
        const int row0 = blk * 64 + F.wave * 8;
        u32x2 fw[16], xw[16], xn[16];
#define CVB4(w) ((f32x4){__builtin_bit_cast(float, (w).x << 16), __builtin_bit_cast(float, (w).x & 0xffff0000u), __builtin_bit_cast(float, (w).y << 16), __builtin_bit_cast(float, (w).y & 0xffff0000u)})
#pragma unroll
        for (int j = 0; j < 16; ++j) { fw[j] = *(const u32x2*)(FF + (size_t)row0 * DM + 4 * F.lane + 256 * j); xw[j] = *(const u32x2*)((const u16*)(F.ws + WS_MERGED) + (size_t)row0 * DM + 4 * F.lane + 256 * j); }
#pragma unroll 1
        for (int ri = 0; ri < 8; ++ri) {
            const int row = row0 + ri;
            f32x4 v[16]; float s = 0.f;
#pragma unroll
            for (int j = 0; j < 16; ++j) { const u32x2 w = fw[j]; v[j] = CVB4(w); s += (v[j].x * v[j].x + v[j].y * v[j].y) + (v[j].z * v[j].z + v[j].w * v[j].w); }
            if (ri < 7) {
#pragma unroll
                for (int j = 0; j < 16; ++j) { fw[j] = *(const u32x2*)(FF + (size_t)(row + 1) * DM + 4 * F.lane + 256 * j); xn[j] = *(const u32x2*)((const u16*)(F.ws + WS_MERGED) + (size_t)(row + 1) * DM + 4 * F.lane + 256 * j); } }
            const float rstd = 1.0f / sqrtf(wave_sum(s) * (1.0f / DM) + RMS_EPS);
            f32x4* xo = (f32x4*)(F.out + (size_t)row * DM) + F.lane;
#pragma unroll
            for (int j = 0; j < 16; ++j) { const u32x2 x = xw[j]; const f32x4 xx = CVB4(x); xo[64 * j] = xx + va[F.lane + 64 * j] * (v[j] * rstd); }
            if (ri < 7) {
#pragma unroll
                for (int j = 0; j < 16; ++j) xw[j] = xn[j]; }
        }
#undef CVB4
    }
}


__device__ __forceinline__ unsigned hash_u(unsigned x) { x ^= x >> 16; x *= 0x7feb352du; x ^= x >> 15; x *= 0x846ca68bu; x ^= x >> 16; return x; }
__device__ __forceinline__ float rf16(float x) { return (float)(f16)x; }
__device__ __forceinline__ void chk_flag(Frame& F, int bit, bool bad) { if (bad && F.lane == 0) atomicOr((unsigned*)(F.ws + WS_CTL) + CW_FLAGS, 1u << bit); }
__device__ __forceinline__ float chk_dot(Frame& F, const u16* A, size_t lda, int row, const float* W, int N, int K, int col) {
    float s = 0.f;
    for (int k = F.lane; k < K; k += 64) s += h2f(A[(size_t)row * lda + k]) * rf16(W[(size_t)k * N + col]);
    return wave_sum(s);
}
__device__ __forceinline__ void chk1_phase(Frame& F) {
    const int gw = F.bid * NWAVES + F.wave;
    for (int s4 = 0; s4 < 4; ++s4) {
        const unsigned s = (unsigned)(gw * 4 + s4); const unsigned h = hash_u(s * 2u + 1u), h2 = hash_u(s * 2u + 2u);
        const int row = (int)(h % (unsigned)M); int col = (int)(h2 % (unsigned)DIN); if ((s & 7u) == 0u) col = 9216 + (int)(h2 % 96u);
        const float ref = chk_dot(F, (const u16*)(F.ws + WS_H), DM, row, F.inp(I_WIN), DIN, DM, col);
        float got;
        if (col < 2048) got = h2f(((const u16*)(F.ws + WS_XL))[(size_t)row * DLRU + col]);
        else if (col < 4096) got = h2f(((const u16*)(F.ws + WS_GATE))[(size_t)row * DLRU + col - 2048]);
        else if (col < 6144) got = h2f(((const u16*)(F.ws + WS_Q))[(size_t)row * DATT + col - 4096]);
        else if (col < 6656) got = h2f(((const u16*)(F.ws + WS_K))[(size_t)row * DKV + col - 6144]);
        else if (col < 7168) got = h2f(((const u16*)(F.ws + WS_V))[(size_t)row * DKV + col - 6656]);
        else if (col < 9216) got = h2f(((const u16*)(F.ws + WS_QI))[(size_t)row * 2048 + col - 7168]);
        else if (col < 9280) got = h2f(((const u16*)(F.ws + WS_KI))[(size_t)row * IDIM + col - 9216]);
        else got = ((const float*)(F.ws + WS_WI))[(size_t)row * NIH + col - 9280];
        chk_flag(F, 4, !(fabsf(got - ref) <= 1.5e-3f * fabsf(ref) + 1.5e-3f));
    }
}
__device__ __forceinline__ void chk2_phase(Frame& F) {
    const int gw = F.bid * NWAVES + F.wave;
    for (int s4 = 0; s4 < 4; ++s4) {
        const unsigned s = (unsigned)(gw * 4 + s4); const unsigned h = hash_u(s * 2u + 11u), h2 = hash_u(s * 2u + 12u);
        const int row = (int)(h % (unsigned)M), col = (int)(h2 % (unsigned)DM);
        const float ref = chk_dot(F, (const u16*)(F.ws + WS_MERGED), DM, row, F.inp(I_WOUT), DM, DM, col);
        const float got = ((const float*)(F.ws + WS_MIX))[(size_t)row * DM + col];
        chk_flag(F, 5, !(fabsf(got - ref) <= 1.0e-3f * fabsf(ref) + 1.0e-3f));
    }
}
__device__ __forceinline__ void chk3_phase(Frame& F) {
    const int gw = F.bid * NWAVES + F.wave;
    for (int s4 = 0; s4 < 4; ++s4) {
        const unsigned s = (unsigned)(gw * 4 + s4); const unsigned h = hash_u(s * 2u + 21u), h2 = hash_u(s * 2u + 22u);
        int row = (int)(h % (unsigned)M); const int f = (int)(h2 % (unsigned)DFF);
        const unsigned m8 = s & 7u;
        if (m8 == 0u) row = (row & ~127); else if (m8 == 1u) row = (row & ~127) + 1; else if (m8 == 2u) row = (row & ~127) + 2; else if (m8 == 3u) row = (row & ~127) + 127;
        else if (m8 == 4u) row = (row & ~7); else if (m8 == 5u) row = (row & ~7) + 1;
        const int t = row % SEQ;
        float ug = F.inp(I_CFB)[f], uu = F.inp(I_CFB)[DFF + f];
        for (int j = 0; j < 3; ++j) { const int ts = t - 2 + j; if (ts < 0) continue; const int rr = row - 2 + j;
            ug += F.inp(I_CFW)[j * DFF2 + f] * chk_dot(F, (const u16*)(F.ws + WS_H), DM, rr, F.inp(I_WFI), DFF2, DM, f);
            uu += F.inp(I_CFW)[j * DFF2 + DFF + f] * chk_dot(F, (const u16*)(F.ws + WS_H), DM, rr, F.inp(I_WFI), DFF2, DM, DFF + f); }
        const float ref = gelu_tanh(ug) * uu;
        const float got = h2f(((const u16*)(F.ws + WS_ACT))[(size_t)row * DFF + f]);
        chk_flag(F, 6, !(fabsf(got - ref) <= 3.0e-3f * fabsf(ref) + 3.0e-3f));
    }
}
__device__ __forceinline__ void chk4_phase(Frame& F) {
    const int gw = F.bid * NWAVES + F.wave;
    for (int s4 = 0; s4 < 4; ++s4) {
        const unsigned s = (unsigned)(gw * 4 + s4); const unsigned h = hash_u(s * 2u + 31u), h2 = hash_u(s * 2u + 32u);
        const int row = (int)(h % (unsigned)M), col = (int)(h2 % (unsigned)DM);
        const float ref = chk_dot(F, (const u16*)(F.ws + WS_ACT), DFF, row, F.inp(I_WFO), DM, DFF, col);
        const float got = ((const float*)(F.ws + WS_MIX))[(size_t)row * DM + col];
        chk_flag(F, 7, !(fabsf(got - ref) <= 1.0e-3f * fabsf(ref) + 1.0e-3f));
    }
}

constexpr int NPH = 12;
struct Args { const float* in[23]; float* out; unsigned char* ws; int ph_lo, ph_hi, li, pad; };
__global__ void __launch_bounds__(NTHR, 2) fwd(Args args) {
    extern __shared__ __attribute__((aligned(16))) unsigned char lds[];
    Frame F;
    F.lds = (LAS unsigned char*)lds; F.ws = args.ws;
    F.tid = threadIdx.x; F.lane = F.tid & 63; F.wave = __builtin_amdgcn_readfirstlane(F.tid >> 6); F.G = gridDim.x; F.bid = blockIdx.x;
    F.kin = (const float* const __attribute__((address_space(4)))*)__builtin_amdgcn_kernarg_segment_ptr();
    F.out = args.out;
    volatile LAS unsigned* MISC = (volatile LAS unsigned*)(F.lds + MISC_OFF);
    for (int u = F.tid; u < (LDS_BYTES - LDSCTL_OFF) / 4; u += NTHR) ((LAS unsigned*)(F.lds + LDSCTL_OFF))[u] = 0u;
    __syncthreads();
    XcdBarrier bar; bar.bar = (unsigned*)(F.ws + WS_CTL) + CW_BAR; bar.x = 0; bar.st = nullptr;
    if (MK_N_LAUNCHES == 1) bar = xcd_barrier_post((unsigned*)(F.ws + WS_CTL) + CW_BAR, MISC + 8);
    const int lo = args.ph_lo, hi = args.ph_hi;
#define IN(k) (lo <= (k) && (k) < hi)
#define SEAM(k) do { if (IN(k) && IN((k) + 1)) xcd_barrier(bar); } while (0)

    if (IN(0)) { p0_phase(F); late_convert<0>(F); __syncthreads(); wq_onepass(F); } SEAM(0);
    if (IN(1)) { p1_phase(F); asm volatile("s_waitcnt vmcnt(0)" ::: "memory"); __syncthreads(); p2b_thin(F); } SEAM(1);
    if (IN(2)) {
        { pg8::Gemm g{(const u16*)(F.ws + WS_H8), (const u16*)(F.ws + WS_WIN8), M, 36 * 256, DM / 2}; pg8::StaticOrder S; S.init(M, 36 * 256, F.G, F.bid);
          pg8::EpiProjQ E{F.ws, (const float*)(F.ws + WS_SA_H1), (const float*)(F.ws + WS_SB_WIN)};
          pg8::gemm_phase<pg8::EpiProjQ>(F.lds, g, S, E); }
    } SEAM(2);
    if (IN(3)) { p3_fast(F); }
    if (IN(4)) { __syncthreads(); p4_fast(F); }
    SEAM(4);
    if (IN(5)) { p5_phase(F); } SEAM(5);
    if (IN(6)) {
        pg8::Gemm g{(const u16*)(F.ws + WS_MERGED), (const u16*)(F.ws + WS_WOUT), M, DM, DM / 2}; pg8::StaticOrder S; S.init(M, DM, F.G, F.bid);
        pg8::EpiB16S8 E{(u16*)(F.ws + WS_MIX), DM};
        pg8::gemm_phase<pg8::EpiB16S8>(F.lds, g, S, E);
    } SEAM(6);
    if (IN(7)) { p7_phase(F); } SEAM(7);
    if (IN(8)) {
        pg8::Gemm g{(const u16*)(F.ws + WS_H), (const u16*)(F.ws + WS_WFI), M, DFF2, DM / 2}; pg8::StaticOrder S; S.init(M, DFF2, F.G, F.bid);
        pg8::EpiFfn E{(u16*)(F.ws + WS_ACT), (float*)(F.ws + WS_HALO), F.inp(I_CFW), F.inp(I_CFB), (const float*)(F.ws + WS_SA_H2), (const float*)(F.ws + WS_SB_WFI)};
        pg8::gemm_phase<pg8::EpiFfn>(F.lds, g, S, E);
        __syncthreads();
        late_convert<1>(F);
    } SEAM(8);
    if (IN(9)) { p9_phase(F); } SEAM(9);
    if (IN(10)) {
        pg8::Gemm g{(const u16*)(F.ws + WS_ACT), (const u16*)(F.ws + WS_WFO), M, DM, DFF / 2}; pg8::StaticOrder S; S.init(M, DM, F.G, F.bid);
        pg8::EpiB16F8 E{(u16*)(F.ws + WS_MIX), DM};
        pg8::gemm_phase<pg8::EpiB16F8>(F.lds, g, S, E);
    } SEAM(10);
    if (IN(11)) { p11_phase(F); }
#undef IN
#undef SEAM
}

#if MK_DIAG
__global__ void __launch_bounds__(NTHR, 2) diag_p4(Args args) {
    extern __shared__ __attribute__((aligned(16))) unsigned char lds[];
    Frame F; F.lds = (LAS unsigned char*)lds; F.ws = args.ws; F.tid = threadIdx.x; F.lane = F.tid & 63; F.wave = __builtin_amdgcn_readfirstlane(F.tid >> 6); F.G = gridDim.x; F.bid = blockIdx.x;
    F.kin = (const float* const __attribute__((address_space(4)))*)__builtin_amdgcn_kernarg_segment_ptr();
    F.out = args.out;
    p4_phase(F);
}
__global__ void diag_scale(Args args) {
    const float v = 1000.0f * fabsf(((const float*)(args.ws + WS_CTL))[CW_FLAGS + 1] / ((const float*)(args.ws + WS_CTL))[CW_FLAGS + 2]);
    for (size_t i = (size_t)blockIdx.x * blockDim.x + threadIdx.x; i < (size_t)M * DM; i += (size_t)gridDim.x * blockDim.x) args.out[i] = args.in[I_X][i] * (1.0f + v);
}
#endif
extern "C" void kernel_launch(void* const* d_in, const int* in_sizes, int n_in, void* d_out, int out_size, void* d_ws, size_t ws_size, hipStream_t stream) {
    static int grid = 0;
    if (grid == 0) {
        if (n_in != 23 || out_size != M * DM || ws_size < WS_END) { fprintf(stderr, "kernel_launch: unexpected shapes (n_in %d, out %d, ws %zu, need %zu)\n", n_in, out_size, ws_size, (size_t)WS_END); grid = -1; return; }
        int dev = 0, cus = 0, per_cu = 0;
        if (hipGetDevice(&dev) != hipSuccess || hipDeviceGetAttribute(&cus, hipDeviceAttributeMultiprocessorCount, dev) != hipSuccess) { grid = -1; return; }
        if (hipFuncSetAttribute((const void*)fwd, hipFuncAttributeMaxDynamicSharedMemorySize, LDS_BYTES) != hipSuccess) { fprintf(stderr, "kernel_launch: hipFuncSetAttribute failed\n"); grid = -1; return; }
        if (hipOccupancyMaxActiveBlocksPerMultiprocessor(&per_cu, (const void*)fwd, NTHR, LDS_BYTES) != hipSuccess || per_cu < 1) fprintf(stderr, "kernel_launch: occupancy query reports %d\n", per_cu);
        (void)hipGetLastError();
        grid = cus;
    }
    if (grid < 0) return;
    (void)hipMemsetAsync((char*)d_ws + WS_CTL, 0, CTL_ZERO_BYTES, stream);
    Args a{};
    for (int i = 0; i < 23; ++i) a.in[i] = (const float*)d_in[i];
    a.out = (float*)d_out; a.ws = (unsigned char*)d_ws;
#if MK_DIAG
    (void)hipFuncSetAttribute((const void*)diag_p4, hipFuncAttributeMaxDynamicSharedMemorySize, LDS_BYTES);
    a.ph_lo = 0; a.ph_hi = 5; a.li = 0; hipLaunchKernelGGL(fwd, dim3(grid), dim3(NTHR), LDS_BYTES, stream, a);
    hipLaunchKernelGGL(diag_p4, dim3(grid), dim3(NTHR), LDS_BYTES, stream, a);
    (void)hipMemsetAsync((char*)d_ws + WS_CTL + CW_BAR * 4, 0, XCD_BAR_WORDS * 4, stream);
    a.ph_lo = 5; a.ph_hi = NPH; a.li = 1; hipLaunchKernelGGL(fwd, dim3(grid), dim3(NTHR), LDS_BYTES, stream, a);
    hipLaunchKernelGGL(diag_scale, dim3(1024), dim3(256), 0, stream, a);
#else
    if (MK_PROBE >= 100) {
        const int k = MK_PROBE - 100;
        a.ph_lo = 0; a.ph_hi = k + 1; a.li = 0; hipLaunchKernelGGL(fwd, dim3(grid), dim3(NTHR), LDS_BYTES, stream, a);
        for (int r = 0; r < MK_PREP; ++r) {
            (void)hipMemsetAsync((char*)d_ws + WS_CTL + CW_BAR * 4, 0, XCD_BAR_WORDS * 4, stream);
            (void)hipMemsetAsync((char*)d_ws + WS_CTL + CW_QUEUE * 4, 0, 4, stream);
            a.ph_lo = k; a.ph_hi = k + 1; a.li = 2; hipLaunchKernelGGL(fwd, dim3(grid), dim3(NTHR), LDS_BYTES, stream, a);
        }
        (void)hipMemsetAsync((char*)d_ws + WS_CTL + CW_BAR * 4, 0, XCD_BAR_WORDS * 4, stream);
        a.ph_lo = k + 1; a.ph_hi = NPH; a.li = 1; hipLaunchKernelGGL(fwd, dim3(grid), dim3(NTHR), LDS_BYTES, stream, a);
    } else if (MK_PROBE >= 0) {
        a.ph_lo = 0; a.ph_hi = MK_PROBE + 1; a.li = 0; hipLaunchKernelGGL(fwd, dim3(grid), dim3(NTHR), LDS_BYTES, stream, a);
        (void)hipMemsetAsync((char*)d_ws + WS_CTL + CW_BAR * 4, 0, XCD_BAR_WORDS * 4, stream);
        a.ph_lo = MK_PROBE; a.ph_hi = NPH; a.li = 1; hipLaunchKernelGGL(fwd, dim3(grid), dim3(NTHR), LDS_BYTES, stream, a);
    } else if (MK_N_LAUNCHES == 1) {
        a.ph_lo = 0; a.ph_hi = NPH; a.li = 0;
        hipLaunchKernelGGL(fwd, dim3(grid), dim3(NTHR), LDS_BYTES, stream, a);
    } else {
        for (int p = 0; p < NPH; ++p) { a.ph_lo = p; a.ph_hi = p + 1; a.li = p; hipLaunchKernelGGL(fwd, dim3(grid), dim3(NTHR), LDS_BYTES, stream, a); }
    }
#endif
}
```
